# Optimizing an MI355X kernel written in HIP

```python
import math
import jax, jax.numpy as jnp
from jax import lax
import numpy as np

D_MODEL = 1024
BATCH = 16
SEQ = 2048
DEPTH = 4
DEC_BATCH = 2
DEC_SEQ = 8192
PAST_LEN = 128

PLE_DIM = 256
SSD_WIDTH = D_MODEL // 2
SSD_HEAD_DIM = 64
SSD_HEADS = SSD_WIDTH // SSD_HEAD_DIM
SSD_GROUPS = 2
SSD_STATE = 128
SSD_CONV = 3
SSD_CHUNK = 128
S5_WIDTH = D_MODEL // 4
S5_GROUP = 16
S5_GROUPS = S5_WIDTH // S5_GROUP
S5_STATE = 64
SGU_WIDTH = D_MODEL // 4
SGU_HEAD_DIM = 64
SGU_HEADS = SGU_WIDTH // SGU_HEAD_DIM
SGU_CHUNK = 128
D_FF = ((8 * D_MODEL // 3) + 127) // 128 * 128
FFN_CONV = 3
EPS = 1e-6

SSD_XBC = SSD_WIDTH + 2 * SSD_GROUPS * SSD_STATE
O_Z = 0
O_XBC = O_Z + SSD_WIDTH
O_DT = O_XBC + SSD_XBC
O_S5 = O_DT + 2 * SSD_HEADS
O_SGU = O_S5 + S5_WIDTH
IN_WIDTH = O_SGU + 2 * SGU_WIDTH

kernel_name = "hybrid_bidir_ssd_s5_sgu_encoder"

F32 = jnp.float32


def rmsnorm(x, w):
    xf = x.astype(F32)
    y = xf * lax.rsqrt(jnp.mean(xf * xf, axis=-1, keepdims=True) + EPS) * w.astype(F32)
    return y.astype(x.dtype)


def layernorm(x, w, b):
    xf = x.astype(F32)
    mu = jnp.mean(xf, axis=-1, keepdims=True)
    xc = xf - mu
    var = jnp.mean(xc * xc, axis=-1, keepdims=True)
    return xc * lax.rsqrt(var + 1e-5) * w.astype(F32) + b.astype(F32)


def dwconv_centred(x, w, b):
    k_w = w.shape[0]
    pad = k_w // 2
    seq = x.shape[1]
    xp = jnp.pad(x, ((0, 0), (pad, k_w - 1 - pad), (0, 0)))
    out = b
    for k in range(k_w):
        out = out + xp[:, k:k + seq] * w[k]
    return out


def ssd_scan(x, dt, a, b_in, c_in):
    bsz, seq, n_h, p_dim = x.shape
    n_g, n_s = b_in.shape[2], b_in.shape[3]
    n_r = n_h // n_g
    n_c = seq // SSD_CHUNK
    xr = (x * dt[..., None]).reshape(bsz, n_c, SSD_CHUNK, n_g, n_r, p_dim)
    adt = jnp.moveaxis((dt * a).reshape(bsz, n_c, SSD_CHUNK, n_g, n_r), 2, -1)
    cs = jnp.cumsum(adt, axis=-1)
    br = b_in.reshape(bsz, n_c, SSD_CHUNK, n_g, n_s)
    cr = c_in.reshape(bsz, n_c, SSD_CHUNK, n_g, n_s)
    lower = jnp.tril(jnp.ones((SSD_CHUNK, SSD_CHUNK), dtype=bool))
    diff = cs[..., :, None] - cs[..., None, :]
    lmat = jnp.exp(jnp.where(lower, diff, -jnp.inf))
    cb = jnp.einsum('bclgn,bcsgn->bcgls', cr, br)
    y_diag = jnp.einsum('bcgls,bcgrls,bcsgrp->bclgrp', cb, lmat, xr)
    decay = jnp.exp(cs[..., -1:] - cs)
    states = jnp.einsum('bclgn,bcgrl,bclgrp->bcgrpn', br, decay, xr)
    chunk_decay = jnp.exp(cs[..., -1])

    def step(h, inp):
        s, d = inp
        return h * d[..., None, None] + s, h

    h0 = jnp.zeros((bsz, n_g, n_r, p_dim, n_s), F32)
    _, states_in = lax.scan(step, h0, (jnp.moveaxis(states, 1, 0), jnp.moveaxis(chunk_decay, 1, 0)))
    states_in = jnp.moveaxis(states_in, 0, 1)
    y_off = jnp.einsum('bclgn,bcgrpn,bcgrl->bclgrp', cr, states_in, jnp.exp(cs))
    return (y_diag + y_off).reshape(bsz, seq, n_h, p_dim)


def ssd_mixer(z, xbc, dt_raw, conv_w, conv_b, dt_bias, a_log, d_skip, norm_w):
    bsz, seq, _ = z.shape
    xbc = jax.nn.silu(dwconv_centred(xbc.astype(F32), conv_w.astype(F32), conv_b.astype(F32)))
    gn = SSD_GROUPS * SSD_STATE
    xs = xbc[..., :SSD_WIDTH].reshape(bsz, seq, SSD_HEADS, SSD_HEAD_DIM)
    bs = xbc[..., SSD_WIDTH:SSD_WIDTH + gn].reshape(bsz, seq, SSD_GROUPS, SSD_STATE)
    cs = xbc[..., SSD_WIDTH + gn:].reshape(bsz, seq, SSD_GROUPS, SSD_STATE)
    dt = jax.nn.softplus(dt_raw.astype(F32).reshape(bsz, seq, 2, SSD_HEADS) + dt_bias.astype(F32))
    a = -jnp.exp(a_log.astype(F32))
    flip = lambda t: jnp.flip(t, axis=1)
    y_f = ssd_scan(xs, dt[:, :, 0], a[0], bs, cs)
    y_b = flip(ssd_scan(flip(xs), flip(dt[:, :, 1]), a[1], flip(bs), flip(cs)))
    y = (y_f + y_b + d_skip.astype(F32)[:, None] * xs).reshape(bsz, seq, SSD_WIDTH)
    y = y * jax.nn.silu(z.astype(F32))
    return rmsnorm(y, norm_w)


def complex_linear_combine(e1, e2):
    a1r, a1i, b1r, b1i = e1
    a2r, a2i, b2r, b2i = e2
    return (a2r * a1r - a2i * a1i,
            a2r * a1i + a2i * a1r,
            a2r * b1r - a2i * b1i + b2r,
            a2r * b1i + a2i * b1r + b2i)


def s5_mixer(u, lam_re, lam_im, log_step, b_re, b_im, c_re, c_im, d_skip, glu_w, glu_b):
    bsz, seq, width = u.shape
    uf = u.astype(F32)
    ug = uf.reshape(bsz, seq, S5_GROUPS, S5_GROUP)
    br, bi = b_re.astype(F32), b_im.astype(F32)
    cr, ci = c_re.astype(F32), c_im.astype(F32)
    y = uf * d_skip.astype(F32)
    for k, rev in ((0, False), (1, True)):
        step = jnp.exp(log_step[k].astype(F32))[:, None]
        lr, li = lam_re[k].astype(F32), lam_im[k].astype(F32)
        mag = jnp.exp(lr * step)
        ab_re, ab_im = mag * jnp.cos(li * step), mag * jnp.sin(li * step)
        den = lr * lr + li * li
        f_re = ((ab_re - 1.0) * lr + ab_im * li) / den
        f_im = (ab_im * lr - (ab_re - 1.0) * li) / den
        bb_re = f_re[..., None] * br - f_im[..., None] * bi
        bb_im = f_re[..., None] * bi + f_im[..., None] * br
        bu_re = jnp.einsum('blgi,gpi->blgp', ug, bb_re)
        bu_im = jnp.einsum('blgi,gpi->blgp', ug, bb_im)
        a_re = jnp.broadcast_to(ab_re, bu_re.shape)
        a_im = jnp.broadcast_to(ab_im, bu_im.shape)
        _, _, s_re, s_im = lax.associative_scan(
            complex_linear_combine, (a_re, a_im, bu_re, bu_im), reverse=rev, axis=1)
        y_dir = jnp.einsum('blgp,gip->blgi', s_re, cr) - jnp.einsum('blgp,gip->blgi', s_im, ci)
        y = y + y_dir.reshape(bsz, seq, width)
    y = jax.nn.gelu(y)
    return y * jax.nn.sigmoid(y @ glu_w.astype(F32) + glu_b.astype(F32))


def sgu_mixer(uv, norm_w, norm_b, w_s, b_s):
    bsz, seq, _ = uv.shape
    uv = jax.nn.gelu(uv.astype(F32))
    u, v = uv[..., :SGU_WIDTH], uv[..., SGU_WIDTH:]
    v = layernorm(v, norm_w, norm_b)
    vr = v.reshape(bsz, seq // SGU_CHUNK, SGU_CHUNK, SGU_HEADS, SGU_HEAD_DIM)
    mixed = jnp.einsum('hts,bcshd->bcthd', w_s.astype(F32), vr) + jnp.transpose(b_s.astype(F32))[:, :, None]
    return u * mixed.reshape(bsz, seq, SGU_WIDTH)


def encoder(x, p, norm_mix, w_in, ssd_conv_w, ssd_conv_b, ssd_dt_bias, ssd_a_log, ssd_d, ssd_norm,
            s5_lambda_re, s5_lambda_im, s5_log_step, s5_b_re, s5_b_im, s5_c_re, s5_c_im, s5_d,
            s5_glu_w, s5_glu_b, s5_out_norm, sgu_norm_w, sgu_norm_b, sgu_w, sgu_b, sgu_out_norm,
            w_out, norm_ffn, ffn_w_up, ffn_conv_w, ffn_conv_b, ffn_w_down,
            ple_proj, ple_norm, ple_gate_w, final_norm):
    for i in range(DEPTH):
        h = rmsnorm(x, norm_mix[i])
        proj = h @ w_in[i]
        y_ssd = ssd_mixer(proj[..., O_Z:O_XBC], proj[..., O_XBC:O_DT], proj[..., O_DT:O_S5],
                          ssd_conv_w[i], ssd_conv_b[i], ssd_dt_bias[i], ssd_a_log[i], ssd_d[i], ssd_norm[i])
        y_s5 = rmsnorm(s5_mixer(proj[..., O_S5:O_SGU], s5_lambda_re[i], s5_lambda_im[i], s5_log_step[i],
                                s5_b_re[i], s5_b_im[i], s5_c_re[i], s5_c_im[i], s5_d[i],
                                s5_glu_w[i], s5_glu_b[i]), s5_out_norm[i])
        y_sgu = rmsnorm(sgu_mixer(proj[..., O_SGU:], sgu_norm_w[i], sgu_norm_b[i], sgu_w[i], sgu_b[i]),
                        sgu_out_norm[i])
        mix = jnp.concatenate([y_ssd, y_s5, y_sgu], axis=-1).astype(x.dtype)
        x = x + mix @ w_out[i]
        h = rmsnorm(x, norm_ffn[i])
        up = dwconv_centred(h @ ffn_w_up[i], ffn_conv_w[i], ffn_conv_b[i])
        gate, val = up[..., :D_FF], up[..., D_FF:]
        x = x + (jax.nn.silu(gate) * val) @ ffn_w_down[i]
        e = p[i] @ ple_proj[i]
        g = jax.nn.sigmoid(rmsnorm(x, ple_norm[i]) @ ple_gate_w[i])
        x = x + g * e
    return rmsnorm(x, final_norm)


def setup_inputs(seed: int = 0) -> dict:
    key = jax.random.key(seed)
    keys = jax.random.split(key, 64)
    counter = [0]

    def nk():
        counter[0] += 1
        return keys[counter[0] - 1]

    def nrm(shape, scale):
        return scale * jax.random.normal(nk(), shape, F32)

    def gain(shape):
        return 1.0 + nrm(shape, 0.02)

    def log_uniform(shape, lo, hi):
        return jax.random.uniform(nk(), shape, F32, minval=math.log(lo), maxval=math.log(hi))

    L = DEPTH
    ssd_dt = jnp.exp(log_uniform((L, 2, SSD_HEADS), 1e-3, 1e-1))
    lam_im = jnp.broadcast_to(math.pi * jnp.arange(S5_STATE, dtype=F32), (L, 2, S5_GROUPS, S5_STATE))
    return {
        "x_prompt": nrm((BATCH, SEQ, D_MODEL), 1.0),
        "x_sample": nrm((DEC_BATCH, DEC_SEQ, D_MODEL), 1.0),
        "p_prompt": nrm((DEPTH, BATCH, SEQ, PLE_DIM), 1.0),
        "p_sample": nrm((DEPTH, DEC_BATCH, DEC_SEQ, PLE_DIM), 1.0),
        "norm_mix": gain((L, D_MODEL)),
        "w_in": nrm((L, D_MODEL, IN_WIDTH), D_MODEL ** -0.5),
        "ssd_conv_w": nrm((L, SSD_CONV, SSD_XBC), SSD_CONV ** -0.5),
        "ssd_conv_b": nrm((L, SSD_XBC), 0.01),
        "ssd_dt_bias": ssd_dt + jnp.log(-jnp.expm1(-ssd_dt)),
        "ssd_a_log": jnp.log(jax.random.uniform(nk(), (L, 2, SSD_HEADS), F32, minval=1.0, maxval=16.0)),
        "ssd_d": gain((L, SSD_HEADS)),
        "ssd_norm": gain((L, SSD_WIDTH)),
        "s5_lambda_re": -0.5 + nrm((L, 2, S5_GROUPS, S5_STATE), 0.01),
        "s5_lambda_im": lam_im,
        "s5_log_step": log_uniform((L, 2, S5_GROUPS), 1e-3, 1e-1),
        "s5_b_re": nrm((L, S5_GROUPS, S5_STATE, S5_GROUP), (2 * S5_GROUP) ** -0.5),
        "s5_b_im": nrm((L, S5_GROUPS, S5_STATE, S5_GROUP), (2 * S5_GROUP) ** -0.5),
        "s5_c_re": nrm((L, S5_GROUPS, S5_GROUP, S5_STATE), S5_STATE ** -0.5),
        "s5_c_im": nrm((L, S5_GROUPS, S5_GROUP, S5_STATE), S5_STATE ** -0.5),
        "s5_d": nrm((L, S5_WIDTH), 1.0),
        "s5_glu_w": nrm((L, S5_WIDTH, S5_WIDTH), S5_WIDTH ** -0.5),
        "s5_glu_b": nrm((L, S5_WIDTH), 0.01),
        "s5_out_norm": gain((L, S5_WIDTH)),
        "sgu_norm_w": gain((L, SGU_WIDTH)),
        "sgu_norm_b": nrm((L, SGU_WIDTH), 0.01),
        "sgu_w": nrm((L, SGU_HEADS, SGU_CHUNK, SGU_CHUNK), SGU_CHUNK ** -0.5),
        "sgu_b": gain((L, SGU_HEADS, SGU_CHUNK)),
        "sgu_out_norm": gain((L, SGU_WIDTH)),
        "w_out": nrm((L, D_MODEL, D_MODEL), D_MODEL ** -0.5),
        "norm_ffn": gain((L, D_MODEL)),
        "ffn_w_up": nrm((L, D_MODEL, 2 * D_FF), D_MODEL ** -0.5),
        "ffn_conv_w": nrm((L, FFN_CONV, 2 * D_FF), FFN_CONV ** -0.5),
        "ffn_conv_b": nrm((L, 2 * D_FF), 0.01),
        "ffn_w_down": nrm((L, D_FF, D_MODEL), D_FF ** -0.5),
        "ple_proj": nrm((L, PLE_DIM, D_MODEL), PLE_DIM ** -0.5),
        "ple_norm": gain((L, D_MODEL)),
        "ple_gate_w": nrm((L, D_MODEL, D_MODEL), D_MODEL ** -0.5),
        "final_norm": gain((D_MODEL,)),
    }


def reference(x_prompt, x_sample, p_prompt, p_sample, norm_mix, w_in, ssd_conv_w, ssd_conv_b,
              ssd_dt_bias, ssd_a_log, ssd_d, ssd_norm, s5_lambda_re, s5_lambda_im, s5_log_step,
              s5_b_re, s5_b_im, s5_c_re, s5_c_im, s5_d, s5_glu_w, s5_glu_b, s5_out_norm,
              sgu_norm_w, sgu_norm_b, sgu_w, sgu_b, sgu_out_norm, w_out, norm_ffn, ffn_w_up,
              ffn_conv_w, ffn_conv_b, ffn_w_down, ple_proj, ple_norm, ple_gate_w, final_norm):
    weights = (norm_mix, w_in, ssd_conv_w, ssd_conv_b, ssd_dt_bias, ssd_a_log, ssd_d, ssd_norm,
               s5_lambda_re, s5_lambda_im, s5_log_step, s5_b_re, s5_b_im, s5_c_re, s5_c_im, s5_d,
               s5_glu_w, s5_glu_b, s5_out_norm, sgu_norm_w, sgu_norm_b, sgu_w, sgu_b, sgu_out_norm,
               w_out, norm_ffn, ffn_w_up, ffn_conv_w, ffn_conv_b, ffn_w_down,
               ple_proj, ple_norm, ple_gate_w, final_norm)
    y_prompt = encoder(x_prompt, p_prompt, *weights)
    y_sample = encoder(x_sample, p_sample, *weights)
    return (y_prompt, y_sample)
```

```cpp
#include <hip/hip_runtime.h>
#include <hip/hip_cooperative_groups.h>
#include <cstdio>
#include <cstdint>
namespace cg = cooperative_groups;
#ifndef SINGLE_LAUNCH
#define SINGLE_LAUNCH 1
#endif
namespace pg8 {
#define PG8_LAS __attribute__((address_space(3)))
typedef unsigned short bf16_t;
typedef short bf16x8 __attribute__((ext_vector_type(8)));
typedef float f32x4 __attribute__((ext_vector_type(4)));
typedef unsigned u32x4 __attribute__((ext_vector_type(4)));
constexpr int BM = 256, BK = 64, HALF = 128, HTB = HALF * BK * 2  , STAGE_BYTES = 8 * HTB, NXCD = 8, WGM = 8;

__host__ __device__ __forceinline__ int lds_byte(int r, int c) { const int st = (r >> 4) * 2 + (c >> 5), rr = r & 15, cc = c & 31, ob = rr * 64 + cc * 2; return st * 1024 + (ob ^ (((ob >> 9) & 1) << 5)); }
__host__ __device__ __forceinline__ void stage_rc(int b, int& R, int& C) { const int st = b / 1024, sb = b % 1024, swz = sb ^ (((sb >> 9) & 1) << 5); R = (st >> 1) * 16 + swz / 64; C = (st & 1) * 32 + (swz % 64) / 2; }
__host__ __device__ __forceinline__ int perm32(int rho) { const int n = rho >> 4, i = rho & 15; return 8 * (i >> 2) + 4 * n + (i & 3); }

struct Unit { int pm, pn; };
struct Gemm { const bf16_t* A; const bf16_t* Bt; int M, N, K; };

struct StaticOrder {
    int nM, nN, nwg, G, c;
    __host__ __device__ void init(int M, int N, int G_, int c_) { nM = M / BM; nN = N / BM; nwg = nM * nN; G = G_; c = c_; }
    __host__ __device__ bool next(int i, Unit& u) const {
        const long L = (long)i * G + c; if (L >= nwg) return false;
        int wgid = (int)L; { const int q = nwg / NXCD, r = nwg % NXCD, xcd = wgid % NXCD, off = wgid / NXCD; wgid = (xcd < r ? xcd * (q + 1) : r * (q + 1) + (xcd - r) * q) + off; }
        const int nig = WGM * nN, gid = wgid / nig, fm = gid * WGM, gsz = (nM - fm) < WGM ? (nM - fm) : WGM;
        u.pm = fm + ((wgid % nig) % gsz); u.pn = (wgid % nig) / gsz; return true;
    }
    __device__ __forceinline__ void a_ready(const Unit&) const {}
    __device__ __forceinline__ void done(const Unit&) const {}
};

template <class Epi, class Sched, bool ALIGN_EPI = false, bool SP2 = false>
__device__ __forceinline__ void gemm_phase(PG8_LAS unsigned char* lds, const Gemm g, const Sched& S, const Epi& E) {
    int tid_ = threadIdx.x; asm volatile("" : "+v"(tid_)); const int tid = tid_, wid = __builtin_amdgcn_readfirstlane(tid >> 6), lane = tid & 63, wr = wid >> 2, wc = wid & 3, fr = lane & 15, fq = lane >> 4;
    const int K = g.K, nt = K / BK;
    unsigned voffA[2], voffB[2];
#pragma unroll
    for (int i = 0; i < 2; ++i) { int R, C; stage_rc(tid * 16 + i * 8192, R, C); const int Rb = Epi::PERM ? ((R & ~31) + perm32(R & 31)) : R;
        voffA[i] = (unsigned)(R * K + C) * 2u; voffB[i] = (unsigned)(Rb * K + C) * 2u; }
    const size_t kstep = (size_t)(BK * 2);
    const size_t hstep = (size_t)HALF * K * 2;
    const size_t tstep = 2 * hstep;
    const unsigned ldsw = (unsigned)wid * 1024u;
    const int aoff = lds_byte(wr * 64 + fr, fq * 8), boff = lds_byte(wc * 32 + fr, fq * 8);
#define PG8_SA(b, h) (((b) * 2 + (h)) * HTB)
#define PG8_SB(b, h) ((4 + (b) * 2 + (h)) * HTB)
#define PG8_STAGE(bufoff, gbase, voff) do { _Pragma("unroll") for (int _i = 0; _i < 2; ++_i) \
        __builtin_amdgcn_global_load_lds((const unsigned*)((const char*)(gbase) + (voff)[_i]), (PG8_LAS unsigned*)(lds + (bufoff) + ldsw + _i * 8192), 16, 0, 0); } while (0)
#define PG8_LDA(dst, b, h) do { _Pragma("unroll") for (int m = 0; m < 4; ++m) _Pragma("unroll") for (int k = 0; k < 2; ++k) dst[m][k] = *(const PG8_LAS bf16x8*)(lds + PG8_SA(b, h) + aoff + m * 2048 + k * 1024); } while (0)
#define PG8_LDB(dst, b, h) do { _Pragma("unroll") for (int n = 0; n < 2; ++n) _Pragma("unroll") for (int k = 0; k < 2; ++k) dst[n][k] = *(const PG8_LAS bf16x8*)(lds + PG8_SB(b, h) + boff + n * 2048 + k * 1024); } while (0)
#define PG8_MMA(ai, bj, At, Bt) do { __builtin_amdgcn_s_setprio(1); _Pragma("unroll") for (int m = 0; m < 4; ++m) _Pragma("unroll") for (int n = 0; n < 2; ++n) _Pragma("unroll") for (int k = 0; k < 2; ++k) \
        acc[ai][bj][m][n] = __builtin_amdgcn_mfma_f32_16x16x32_bf16(Bt[n][k], At[m][k], acc[ai][bj][m][n], 0, 0, 0); __builtin_amdgcn_s_setprio(0); } while (0)
#define PG8_WAIT_V(n) asm volatile("s_waitcnt vmcnt(" #n ")" ::: "memory")
#define PG8_WAIT_L(n) asm volatile("s_waitcnt lgkmcnt(" #n ")" ::: "memory")
#define PG8_BAR __builtin_amdgcn_s_barrier()
#define PG8_SCHED __builtin_amdgcn_sched_barrier(0)
    Unit cur, nxt; int ui = 0;
    if (!S.next(0, cur)) return;
    f32x4 acc[2][2][4][2];
#pragma unroll
    for (int a = 0; a < 2; ++a)
#pragma unroll
        for (int b = 0; b < 2; ++b)
#pragma unroll
            for (int m = 0; m < 4; ++m)
#pragma unroll
                for (int n = 0; n < 2; ++n) acc[a][b][m][n] = (f32x4){0.f, 0.f, 0.f, 0.f};
    bf16x8 At[4][2], B0[2][2], B1[2][2];
    const char* cA = (const char*)g.A + (size_t)cur.pm * tstep; const char* cB = (const char*)g.Bt + (size_t)cur.pn * tstep;
    S.a_ready(cur);
    if constexpr (SP2) {
        PG8_STAGE(PG8_SB(0, 0), cB, voffB); PG8_STAGE(PG8_SB(0, 1), cB + hstep, voffB); PG8_STAGE(PG8_SA(0, 0), cA, voffA); PG8_STAGE(PG8_SA(0, 1), cA + hstep, voffA);
        if (wr == 1) PG8_BAR;
        PG8_WAIT_V(2); PG8_BAR;
        PG8_STAGE(PG8_SB(1, 0), cB + kstep, voffB); PG8_STAGE(PG8_SA(1, 0), cA + kstep, voffA); PG8_STAGE(PG8_SB(1, 1), cB + hstep + kstep, voffB);
        PG8_WAIT_V(6); PG8_BAR;
    } else {
        PG8_STAGE(PG8_SB(0, 0), cB, voffB); PG8_STAGE(PG8_SA(0, 0), cA, voffA); PG8_STAGE(PG8_SB(0, 1), cB + hstep, voffB); PG8_STAGE(PG8_SA(0, 1), cA + hstep, voffA);
        if (wr == 1) PG8_BAR;
        PG8_WAIT_V(4); PG8_BAR;
        PG8_STAGE(PG8_SB(1, 0), cB + kstep, voffB); PG8_STAGE(PG8_SA(1, 0), cA + kstep, voffA); PG8_STAGE(PG8_SB(1, 1), cB + hstep + kstep, voffB);
        PG8_WAIT_V(6); PG8_BAR;
    }
    for (;;) {
        const bool has_next = S.next(ui + 1, nxt);
        const char* nA = has_next ? (const char*)g.A + (size_t)nxt.pm * tstep : cA; const char* nB = has_next ? (const char*)g.Bt + (size_t)nxt.pn * tstep : cB;
        for (int t = 0; t < nt; t += 2) {
            const bool last = (t == nt - 2);
            const char* a1 = cA + (size_t)(t + 1) * kstep;
            const char* a2 = last ? nA : cA + (size_t)(t + 2) * kstep; const char* b2 = last ? nB : cB + (size_t)(t + 2) * kstep;
            const char* a3 = a2 + kstep; const char* b3 = b2 + kstep;
            if (last && has_next) S.a_ready(nxt);
            if constexpr (SP2) {
            PG8_LDB(B0, 0, 0); PG8_LDB(B1, 0, 1); PG8_SCHED; PG8_LDA(At, 0, 0); PG8_STAGE(PG8_SA(1, 1), a1 + hstep, voffA);
            PG8_WAIT_V(8); PG8_WAIT_L(0); PG8_BAR; PG8_MMA(0, 0, At, B0); PG8_MMA(0, 1, At, B1); PG8_BAR; PG8_SCHED;
            PG8_LDA(At, 0, 1); PG8_STAGE(PG8_SB(0, 0), b2, voffB); PG8_STAGE(PG8_SB(0, 1), b2 + hstep, voffB); PG8_STAGE(PG8_SA(0, 0), a2, voffA);
            PG8_WAIT_V(8); PG8_WAIT_L(0); PG8_BAR; PG8_MMA(1, 0, At, B0); PG8_MMA(1, 1, At, B1); PG8_BAR; PG8_SCHED;
            PG8_LDB(B0, 1, 0); PG8_LDB(B1, 1, 1); PG8_SCHED; PG8_LDA(At, 1, 0); PG8_STAGE(PG8_SA(0, 1), a2 + hstep, voffA);
            PG8_WAIT_V(8); PG8_WAIT_L(0); PG8_BAR; PG8_MMA(0, 0, At, B0); PG8_MMA(0, 1, At, B1); PG8_BAR; PG8_SCHED;
            PG8_LDA(At, 1, 1); PG8_STAGE(PG8_SB(1, 0), b3, voffB); PG8_STAGE(PG8_SB(1, 1), b3 + hstep, voffB); PG8_STAGE(PG8_SA(1, 0), a3, voffA);
            PG8_WAIT_V(8); PG8_WAIT_L(0); PG8_BAR; PG8_MMA(1, 0, At, B0); PG8_MMA(1, 1, At, B1); PG8_BAR; PG8_SCHED;
            } else {
            PG8_LDB(B0, 0, 0); PG8_SCHED; PG8_LDA(At, 0, 0); PG8_STAGE(PG8_SA(1, 1), a1 + hstep, voffA);
            PG8_WAIT_L(8); PG8_BAR; PG8_WAIT_L(0); PG8_MMA(0, 0, At, B0); PG8_BAR; PG8_SCHED;
            PG8_LDB(B1, 0, 1); PG8_STAGE(PG8_SB(0, 0), b2, voffB);
            PG8_BAR; PG8_WAIT_L(0); PG8_MMA(0, 1, At, B1); PG8_BAR;
            PG8_LDA(At, 0, 1); PG8_STAGE(PG8_SA(0, 0), a2, voffA);
            PG8_BAR; PG8_WAIT_L(0); PG8_MMA(1, 0, At, B0); PG8_BAR; PG8_SCHED;
            PG8_STAGE(PG8_SB(0, 1), b2 + hstep, voffB);
            PG8_WAIT_V(6); PG8_BAR; PG8_MMA(1, 1, At, B1); PG8_BAR;
            PG8_LDB(B0, 1, 0); PG8_SCHED; PG8_LDA(At, 1, 0); PG8_STAGE(PG8_SA(0, 1), a2 + hstep, voffA);
            PG8_WAIT_L(8); PG8_BAR; PG8_WAIT_L(0); PG8_MMA(0, 0, At, B0); PG8_BAR; PG8_SCHED;
            PG8_LDB(B1, 1, 1); PG8_STAGE(PG8_SB(1, 0), b3, voffB);
            PG8_BAR; PG8_WAIT_L(0); PG8_MMA(0, 1, At, B1); PG8_BAR;
            PG8_LDA(At, 1, 1); PG8_STAGE(PG8_SA(1, 0), a3, voffA);
            PG8_BAR; PG8_WAIT_L(0); PG8_MMA(1, 0, At, B0); PG8_BAR; PG8_SCHED;
            PG8_STAGE(PG8_SB(1, 1), b3 + hstep, voffB);
            PG8_WAIT_V(6); PG8_BAR; PG8_MMA(1, 1, At, B1); PG8_BAR;
            }
        }
        if constexpr (ALIGN_EPI) { if (wr == 0) PG8_BAR; }
        if constexpr (!Epi::AFTER_DRAIN) { E(acc, cur, wr, wc, fr, fq); S.done(cur); }
        if (!has_next) break;
#pragma unroll
        for (int a = 0; a < 2; ++a)
#pragma unroll
            for (int b = 0; b < 2; ++b)
#pragma unroll
                for (int m = 0; m < 4; ++m)
#pragma unroll
                    for (int n = 0; n < 2; ++n) acc[a][b][m][n] = (f32x4){0.f, 0.f, 0.f, 0.f};
        cur = nxt; cA = nA; cB = nB; ++ui;
        if constexpr (ALIGN_EPI) { if (wr == 1) PG8_BAR; }
    }
    PG8_WAIT_V(0);
    if constexpr (!ALIGN_EPI) { if (wr == 0) PG8_BAR; }
    PG8_BAR;
    if constexpr (Epi::AFTER_DRAIN) { E.fused(acc, cur, wr, wc, fr, fq, lds, wid, lane); S.done(cur); }
#undef PG8_SA
#undef PG8_SB
#undef PG8_STAGE
#undef PG8_LDA
#undef PG8_LDB
#undef PG8_MMA
#undef PG8_WAIT_V
#undef PG8_WAIT_L
#undef PG8_BAR
#undef PG8_SCHED
}
}
using pg8::bf16_t; using pg8::bf16x8; using pg8::f32x4; using pg8::u32x4; using pg8::Unit;
typedef short bf16x4 __attribute__((ext_vector_type(4)));
typedef unsigned u32x2 __attribute__((ext_vector_type(2)));
typedef float f32x2v __attribute__((ext_vector_type(2)));

constexpr int M_TOK = 49152, MP = 32768, DM = 1024, INW = 2320, INP = 2560, DFF = 2816, UPW = 5632, PLE = 256;
constexpr int O_XBC = 512, O_DT = 1536, O_S5 = 1552, O_SGU = 1808;
constexpr int NCHUNK = 384, SLAB = 16384, NSLAB = 3, NLAYER = 4;
constexpr int LDS_BYTES = 147456;
constexpr int PH_PER_LAYER = 10, N_PHASES = NLAYER * PH_PER_LAYER + 2;

constexpr size_t SZ_XBF = (size_t)M_TOK * 1024 * 2;
constexpr size_t SZ_PROJ = (size_t)M_TOK * INW * 2;
constexpr size_t SZ_STATES = (size_t)NCHUNK * 2 * 8 * 8192 * 2;
constexpr size_t SZ_S5Y = (size_t)2 * M_TOK * 256 * 2;
constexpr size_t SZ_UP = (size_t)SLAB * UPW * 2;
constexpr size_t SZ_ACT = (size_t)SLAB * DFF * 2;
constexpr size_t R_PROJ = 0, R_STATES = SZ_PROJ, R_MIX = R_STATES + SZ_STATES, R_S5Y = R_MIX + SZ_XBF, R_END = R_S5Y + SZ_S5Y;
constexpr size_t R_XBF = 0, R_UP = SZ_XBF, R_ACT = R_UP + SZ_UP, R_XALT = R_ACT + SZ_ACT, R_E = R_XALT;
static_assert(R_XALT + SZ_XBF <= R_END, "xalt must fit");
static_assert(R_XALT >= SZ_PROJ, "xalt must not overlap proj");
constexpr size_t W_WIN = R_END;
constexpr size_t W_WOUT = W_WIN + (size_t)INP * 1024 * 2;
constexpr size_t W_WUP = W_WOUT + (size_t)1024 * 1024 * 2;
constexpr size_t W_WDOWN = W_WUP + (size_t)UPW * 1024 * 2;
constexpr size_t W_WP = W_WDOWN + (size_t)1024 * DFF * 2;
constexpr size_t W_WG = W_WP + (size_t)1024 * 256 * 2;
constexpr size_t W_GLU = W_WG + (size_t)1024 * 1024 * 2;
constexpr size_t W_SGU = W_GLU + (size_t)256 * 256 * 2;
constexpr size_t W_PBF = W_SGU + (size_t)4 * 128 * 128 * 2;
constexpr size_t W_DT = W_PBF + (size_t)M_TOK * 256 * 2;
constexpr size_t W_PARTA = W_DT + (size_t)M_TOK * 16 * 4;
constexpr size_t W_PARTB = W_PARTA + (size_t)M_TOK * 16 * 4;
constexpr size_t W_SSQ = W_PARTB + (size_t)M_TOK * 16 * 4;
constexpr size_t W_DECAY = W_SSQ + (size_t)M_TOK * 2 * 4;
constexpr size_t W_HLOC = W_DECAY + (size_t)NCHUNK * 16 * 4;
constexpr size_t W_HIN = W_HLOC + (size_t)NCHUNK * 2 * 16 * 64 * 8;
constexpr size_t W_AB = W_HIN + (size_t)NCHUNK * 2 * 16 * 64 * 8;
constexpr size_t W_ABL = W_AB + (size_t)2 * 16 * 64 * 8;
constexpr size_t W_BOP = W_ABL + (size_t)2 * 16 * 64 * 8;
constexpr size_t W_COP = W_BOP + (size_t)2 * 16 * 128 * 16 * 2;
constexpr size_t W_EDGE = W_COP + (size_t)16 * 16 * 128 * 2;
constexpr size_t W_BAR = W_EDGE + (size_t)(M_TOK / 256) * 4 * 2 * DFF * 2;
constexpr size_t W2_BASE = W_BAR + 16384;
constexpr size_t WS_TOTAL = W2_BASE + (W_PBF - W_WIN) + (W_EDGE - W_AB);
__host__ __device__ __forceinline__ size_t woff(size_t off, int layer) { return !(layer & 1) ? off : (off < W_PBF ? W2_BASE + (off - W_WIN) : W2_BASE + (W_PBF - W_WIN) + (off - W_AB)); }

struct Params {
    const float* in[38];
    float* out; unsigned char* ws;
    int ph_lo, ph_hi;
};
typedef const __attribute__((address_space(4))) unsigned char* kaptr_t;
struct Ctx {
    kaptr_t ka; int rep;
    __device__ __forceinline__ const float* in(int i) const { return *(const float* const __attribute__((address_space(4)))*)(ka + 8 * i); }
    __device__ __forceinline__ float* out() const { return *(float* const __attribute__((address_space(4)))*)(ka + 8 * 38); }
    __device__ __forceinline__ unsigned char* ws() const { return *(unsigned char* const __attribute__((address_space(4)))*)(ka + 8 * 39); }
};
enum { I_XP = 0, I_XS, I_PP, I_PS, I_NORM_MIX, I_W_IN, I_SSD_CW, I_SSD_CB, I_SSD_DTB, I_SSD_ALOG, I_SSD_D, I_SSD_NORM, I_S5_LRE, I_S5_LIM, I_S5_LSTEP,
       I_S5_BRE, I_S5_BIM, I_S5_CRE, I_S5_CIM, I_S5_D, I_S5_GLUW, I_S5_GLUB, I_S5_ONORM, I_SGU_NW, I_SGU_NB, I_SGU_W, I_SGU_B, I_SGU_ONORM, I_W_OUT, I_NORM_FFN,
       I_FFN_UP, I_FFN_CW, I_FFN_CB, I_FFN_DOWN, I_PLE_PROJ, I_PLE_NORM, I_PLE_GATE, I_FINAL_NORM };

__device__ __forceinline__ int ltid() { int t = threadIdx.x; asm volatile("" : "+v"(t)); return t; }
__device__ __forceinline__ float bflo(unsigned w) { return __uint_as_float(w << 16); }
__device__ __forceinline__ float bfhi(unsigned w) { return __uint_as_float(w & 0xffff0000u); }
__device__ __forceinline__ float bf2f(bf16_t b) { return __uint_as_float(((unsigned)b) << 16); }
typedef __bf16 nbf16x2 __attribute__((ext_vector_type(2)));
__device__ __forceinline__ unsigned pk2(float lo, float hi) { f32x2v v; v.x = lo; v.y = hi; const nbf16x2 b = __builtin_convertvector(v, nbf16x2); return __builtin_bit_cast(unsigned, b); }
__device__ __forceinline__ bf16_t f2bf(float f) { return (bf16_t)(pk2(f, 0.f) & 0xffffu); }
__device__ __forceinline__ void unpack8(const u32x4 r, float (&v)[8]) { v[0] = bflo(r.x); v[1] = bfhi(r.x); v[2] = bflo(r.y); v[3] = bfhi(r.y); v[4] = bflo(r.z); v[5] = bfhi(r.z); v[6] = bflo(r.w); v[7] = bfhi(r.w); }
__device__ __forceinline__ u32x4 pack8(const float (&v)[8]) { u32x4 o; o.x = pk2(v[0], v[1]); o.y = pk2(v[2], v[3]); o.z = pk2(v[4], v[5]); o.w = pk2(v[6], v[7]); return o; }
__device__ __forceinline__ float sigmoidf_(float x) { return __builtin_amdgcn_rcpf(1.0f + __builtin_amdgcn_exp2f(x * -1.4426950408889634f)); }
__device__ __forceinline__ float siluf_(float x) { return x * sigmoidf_(x); }
__device__ __forceinline__ float geluf_(float x) { const float u = 0.7978845608f * (x + 0.044715f * x * x * x); return x * sigmoidf_(2.0f * u); }
__device__ __forceinline__ float softplusf_(float x) { return x > 20.f ? x : log1pf(__expf(x)); }
__device__ __forceinline__ bool tok_first(int t) { return t < MP ? ((t & 2047) == 0) : (((t - MP) & 8191) == 0); }
__device__ __forceinline__ bool tok_last(int t) { return t < MP ? ((t & 2047) == 2047) : (((t - MP) & 8191) == 8191); }
__device__ __forceinline__ float wave_incl_scan(float v, int lane) {
#pragma unroll
    for (int o = 1; o < 64; o <<= 1) { const float t = __shfl_up(v, o); if (lane >= o) v += t; }
    return v;
}
__device__ __forceinline__ float row_rstd16(const float* part, int row) {
    const f32x4* p = (const f32x4*)(part + (size_t)row * 16);
    const f32x4 a = p[0], b = p[1], c = p[2], d = p[3];
    const float s = (((a[0] + a[1]) + (a[2] + a[3])) + ((b[0] + b[1]) + (b[2] + b[3]))) + (((c[0] + c[1]) + (c[2] + c[3])) + ((d[0] + d[1]) + (d[2] + d[3])));
    return rsqrtf(s * (1.0f / 1024.0f) + 1e-6f);
}
struct RowRs { float s0, s1; };
__device__ __forceinline__ RowRs rowrs_load(const float* part, int rowbase  , int lane) {
    RowRs r; const int rr = rowbase + (lane >> 4) * 16 + (lane & 15); r.s0 = row_rstd16(part, rr); r.s1 = row_rstd16(part, rr + 128); return r;
}
__device__ __forceinline__ float rowrs_get(const RowRs& r, int ai, int m, int fr) { return __shfl(ai ? r.s1 : r.s0, m * 16 + fr); }
__device__ __forceinline__ int prow(int j, int i) { return 32 * (j >> 1) + 8 * (i >> 2) + 4 * (j & 1) + (i & 3); }
#define MFMA32(a, b, c) __builtin_amdgcn_mfma_f32_16x16x32_bf16((a), (b), (c), 0, 0, 0)
#define MFMA16(a, b, c) __builtin_amdgcn_mfma_f32_16x16x16bf16_1k((a), (b), (c), 0, 0, 0)
#define WAVE_LDS_FENCE() do { asm volatile("s_waitcnt lgkmcnt(0)" ::: "memory"); __builtin_amdgcn_wave_barrier(); } while (0)

#ifndef GEMM_ALIGN_EPI
#define GEMM_ALIGN_EPI true
#endif
#ifndef GEMM_SP2
#define GEMM_SP2 true
#endif
struct EpiProj {
    static constexpr bool PERM = true, AFTER_DRAIN = false;
    bf16_t* proj; float* dt; const float* part;
    __device__ __forceinline__ void operator()(const f32x4 (&acc)[2][2][4][2], const Unit& u, int wr, int wc, int fr, int fq) const {
        const int row0 = u.pm * 256 + wr * 64 + fr, colb = u.pn * 256 + wc * 32 + 8 * fq;
        const RowRs rr = rowrs_load(part, u.pm * 256 + wr * 64, fq * 16 + fr);
#pragma unroll
        for (int ai = 0; ai < 2; ++ai)
#pragma unroll
            for (int m = 0; m < 4; ++m) {
                const int row = row0 + ai * 128 + m * 16; const float rs = rowrs_get(rr, ai, m, fr);
#pragma unroll
                for (int bj = 0; bj < 2; ++bj) {
                    const int col = colb + bj * 128; const f32x4 v0 = acc[ai][bj][m][0] * rs, v1 = acc[ai][bj][m][1] * rs;
                    if (col < INW) { u32x4 w; w.x = pk2(v0[0], v0[1]); w.y = pk2(v0[2], v0[3]); w.z = pk2(v1[0], v1[1]); w.w = pk2(v1[2], v1[3]); *(u32x4*)(proj + (size_t)row * INW + col) = w; }
                    if (col >= O_DT && col < O_DT + 16) { float* d = dt + (size_t)row * 16 + (col - O_DT); *(f32x4*)d = v0; *(f32x4*)(d + 4) = v1; }
                }
            }
    }
};
template <bool SCALE> struct EpiBf16S {
    static constexpr bool PERM = true, AFTER_DRAIN = false;
    bf16_t* O; int ldc; const float* part;
    __device__ __forceinline__ void operator()(const f32x4 (&acc)[2][2][4][2], const Unit& u, int wr, int wc, int fr, int fq) const {
        const int row0 = u.pm * 256 + wr * 64 + fr, colb = u.pn * 256 + wc * 32 + 8 * fq;
        RowRs rr; rr.s0 = 1.f; rr.s1 = 1.f; if (SCALE) rr = rowrs_load(part, u.pm * 256 + wr * 64, fq * 16 + fr);
#pragma unroll
        for (int ai = 0; ai < 2; ++ai)
#pragma unroll
            for (int m = 0; m < 4; ++m) {
                const int row = row0 + ai * 128 + m * 16; float rs = 1.0f; if (SCALE) rs = rowrs_get(rr, ai, m, fr);
#pragma unroll
                for (int bj = 0; bj < 2; ++bj) {
                    const int col = colb + bj * 128; const f32x4 v0 = acc[ai][bj][m][0] * rs, v1 = acc[ai][bj][m][1] * rs;
                    u32x4 w; w.x = pk2(v0[0], v0[1]); w.y = pk2(v0[2], v0[3]); w.z = pk2(v1[0], v1[1]); w.w = pk2(v1[2], v1[3]); *(u32x4*)(O + (size_t)row * ldc + col) = w;
                }
            }
    }
};
template <bool GATE> struct EpiResid {
    static constexpr bool PERM = true, AFTER_DRAIN = false;
    const bf16_t* xin; bf16_t* xout; float* part_out; const float* part_in; const bf16_t* e; int rep;
    __device__ __forceinline__ void operator()(const f32x4 (&acc)[2][2][4][2], const Unit& u, int wr, int wc, int fr, int fq) const {
        const int row0 = u.pm * 256 + wr * 64 + fr, colb = u.pn * 256 + wc * 32 + 8 * fq;
        RowRs rr; rr.s0 = 1.f; rr.s1 = 1.f; if (GATE) rr = rowrs_load(part_in, u.pm * 256 + wr * 64, fq * 16 + fr);
#pragma unroll
        for (int ai = 0; ai < 2; ++ai)
#pragma unroll
            for (int m = 0; m < 4; ++m) {
                const int row = row0 + ai * 128 + m * 16; float rs = 1.0f; if (GATE) rs = rowrs_get(rr, ai, m, fr);
                float ss = 0.f;
#pragma unroll
                for (int bj = 0; bj < 2; ++bj) {
                    const size_t o = (size_t)row * 1024 + colb + bj * 128;
                    float v[8]; unpack8(*(const u32x4*)(xin + o), v);
                    const f32x4 a0 = acc[ai][bj][m][0], a1 = acc[ai][bj][m][1];
                    if (GATE) { float ev[8]; unpack8(*(const u32x4*)(e + o), ev);
#pragma unroll
                        for (int j = 0; j < 4; ++j) { v[j] += sigmoidf_(a0[j] * rs) * ev[j]; v[4 + j] += sigmoidf_(a1[j] * rs) * ev[4 + j]; } }
                    else {
#pragma unroll
                        for (int j = 0; j < 4; ++j) { v[j] += a0[j]; v[4 + j] += a1[j]; } }
                    if (rep == 0) *(u32x4*)(xout + o) = pack8(v);
#pragma unroll
                    for (int j = 0; j < 8; ++j) ss += v[j] * v[j];
                }
                ss += __shfl_xor(ss, 16); ss += __shfl_xor(ss, 32);
                if (fq == 0 && rep == 0) part_out[(size_t)row * 16 + u.pn * 4 + wc] = ss;
                if (m == 1 || m == 3) asm volatile("" ::: "memory");
            }
    }
};
struct EpiUpConv {
    static constexpr bool PERM = true, AFTER_DRAIN = false;
    bf16_t* act; bf16_t* edge; const float* part; const float* cw; const float* cb; unsigned* xbuf;
    __device__ __forceinline__ void operator()(const f32x4 (&acc)[2][2][4][2], const Unit& u, int wr, int wc, int fr, int fq) const {
        const int lane = fq * 16 + fr; const int ch0 = u.pn * 128 + wc * 32 + 8 * fq;
        const RowRs rr = rowrs_load(part, u.pm * 256 + wr * 64, lane);
        unsigned G[2][4][4], V[2][4][4];
#pragma unroll
        for (int ai = 0; ai < 2; ++ai)
#pragma unroll
            for (int m = 0; m < 4; ++m) { const float rs = rowrs_get(rr, ai, m, fr);
                const f32x4 g0 = acc[ai][0][m][0] * rs, g1 = acc[ai][0][m][1] * rs, v0 = acc[ai][1][m][0] * rs, v1 = acc[ai][1][m][1] * rs;
                G[ai][m][0] = pk2(g0[0], g0[1]); G[ai][m][1] = pk2(g0[2], g0[3]); G[ai][m][2] = pk2(g1[0], g1[1]); G[ai][m][3] = pk2(g1[2], g1[3]);
                V[ai][m][0] = pk2(v0[0], v0[1]); V[ai][m][1] = pk2(v0[2], v0[3]); V[ai][m][2] = pk2(v1[0], v1[1]); V[ai][m][3] = pk2(v1[2], v1[3]); }
#pragma unroll
        for (int ai = 0; ai < 2; ++ai) { const int g4 = 2 * ai + wr;
            if (fr == 0) { unsigned* d = xbuf + ((((g4 * 2 + 0) * 4 + wc) * 4 + fq) * 8); *(u32x4*)d = (u32x4){G[ai][0][0], G[ai][0][1], G[ai][0][2], G[ai][0][3]}; *(u32x4*)(d + 4) = (u32x4){V[ai][0][0], V[ai][0][1], V[ai][0][2], V[ai][0][3]}; }
            if (fr == 15) { unsigned* d = xbuf + ((((g4 * 2 + 1) * 4 + wc) * 4 + fq) * 8); *(u32x4*)d = (u32x4){G[ai][3][0], G[ai][3][1], G[ai][3][2], G[ai][3][3]}; *(u32x4*)(d + 4) = (u32x4){V[ai][3][0], V[ai][3][1], V[ai][3][2], V[ai][3][3]}; } }
        if (wr == 0 && fr < 2) { bf16_t* d = edge + ((size_t)(u.pm * 4 + fr) * 2) * DFF + ch0; *(u32x4*)d = (u32x4){G[0][0][0], G[0][0][1], G[0][0][2], G[0][0][3]}; *(u32x4*)(d + DFF) = (u32x4){V[0][0][0], V[0][0][1], V[0][0][2], V[0][0][3]}; }
        if (wr == 1 && fr >= 14) { bf16_t* d = edge + ((size_t)(u.pm * 4 + 2 + (fr - 14)) * 2) * DFF + ch0; *(u32x4*)d = (u32x4){G[1][3][0], G[1][3][1], G[1][3][2], G[1][3][3]}; *(u32x4*)(d + DFF) = (u32x4){V[1][3][0], V[1][3][1], V[1][3][2], V[1][3][3]}; }
        asm volatile("s_waitcnt lgkmcnt(0)" ::: "memory"); __builtin_amdgcn_s_barrier(); asm volatile("" ::: "memory");
        if (!GEMM_ALIGN_EPI) { __builtin_amdgcn_s_barrier(); asm volatile("" ::: "memory"); }
        float wg[3][8], wv[3][8], bg[8], bv[8];
#pragma unroll
        for (int k = 0; k < 3; ++k)
#pragma unroll
            for (int hlf = 0; hlf < 2; ++hlf) { const f32x4 a = *(const f32x4*)(cw + k * UPW + ch0 + 4 * hlf), b = *(const f32x4*)(cw + k * UPW + DFF + ch0 + 4 * hlf);
#pragma unroll
                for (int j = 0; j < 4; ++j) { wg[k][4 * hlf + j] = a[j]; wv[k][4 * hlf + j] = b[j]; } }
#pragma unroll
        for (int hlf = 0; hlf < 2; ++hlf) { const f32x4 a = *(const f32x4*)(cb + ch0 + 4 * hlf), b = *(const f32x4*)(cb + DFF + ch0 + 4 * hlf);
#pragma unroll
            for (int j = 0; j < 4; ++j) { bg[4 * hlf + j] = a[j]; bv[4 * hlf + j] = b[j]; } }
        const int row0 = u.pm * 256 + wr * 64 + fr;
#pragma unroll
        for (int ai = 0; ai < 2; ++ai) { const int g4 = 2 * ai + wr;
            u32x4 xpg = {0u, 0u, 0u, 0u}, xpv = xpg, xng = xpg, xnv = xpg;
            if (g4 > 0) { const unsigned* d = xbuf + (((((g4 - 1) * 2 + 1) * 4 + wc) * 4 + fq) * 8); xpg = *(const u32x4*)d; xpv = *(const u32x4*)(d + 4); }
            if (g4 < 3) { const unsigned* d = xbuf + (((((g4 + 1) * 2 + 0) * 4 + wc) * 4 + fq) * 8); xng = *(const u32x4*)d; xnv = *(const u32x4*)(d + 4); }
#pragma unroll
            for (int m = 0; m < 4; ++m) {
                unsigned pg[4], pv[4], ng[4], nv[4];
#pragma unroll
                for (int e = 0; e < 4; ++e) {
                    const unsigned sg = (m > 0 && fr == 15) ? G[ai][m > 0 ? m - 1 : 0][e] : G[ai][m][e], sv = (m > 0 && fr == 15) ? V[ai][m > 0 ? m - 1 : 0][e] : V[ai][m][e];
                    const unsigned tg = (m < 3 && fr == 0) ? G[ai][m < 3 ? m + 1 : 3][e] : G[ai][m][e], tv = (m < 3 && fr == 0) ? V[ai][m < 3 ? m + 1 : 3][e] : V[ai][m][e];
                    pg[e] = (unsigned)__builtin_amdgcn_mov_dpp((int)sg, 0x121, 0xf, 0xf, false); pv[e] = (unsigned)__builtin_amdgcn_mov_dpp((int)sv, 0x121, 0xf, 0xf, false);
                    ng[e] = (unsigned)__builtin_amdgcn_mov_dpp((int)tg, 0x12F, 0xf, 0xf, false); nv[e] = (unsigned)__builtin_amdgcn_mov_dpp((int)tv, 0x12F, 0xf, 0xf, false);
                    if (m == 0) { pg[e] = fr == 0 ? xpg[e] : pg[e]; pv[e] = fr == 0 ? xpv[e] : pv[e]; }
                    if (m == 3) { ng[e] = fr == 15 ? xng[e] : ng[e]; nv[e] = fr == 15 ? xnv[e] : nv[e]; }
                }
                float o[8];
#pragma unroll
                for (int e = 0; e < 4; ++e) {
                    const float g_lo = bg[2 * e] + wg[0][2 * e] * bflo(pg[e]) + wg[1][2 * e] * bflo(G[ai][m][e]) + wg[2][2 * e] * bflo(ng[e]);
                    const float g_hi = bg[2 * e + 1] + wg[0][2 * e + 1] * bfhi(pg[e]) + wg[1][2 * e + 1] * bfhi(G[ai][m][e]) + wg[2][2 * e + 1] * bfhi(ng[e]);
                    const float v_lo = bv[2 * e] + wv[0][2 * e] * bflo(pv[e]) + wv[1][2 * e] * bflo(V[ai][m][e]) + wv[2][2 * e] * bflo(nv[e]);
                    const float v_hi = bv[2 * e + 1] + wv[0][2 * e + 1] * bfhi(pv[e]) + wv[1][2 * e + 1] * bfhi(V[ai][m][e]) + wv[2][2 * e + 1] * bfhi(nv[e]);
                    o[2 * e] = siluf_(g_lo) * v_lo; o[2 * e + 1] = siluf_(g_hi) * v_hi; }
                *(u32x4*)(act + (size_t)(row0 + ai * 128 + m * 16) * DFF + ch0) = pack8(o);
            }
        }
    }
};
__device__ __forceinline__ void ffn_fixup_phase(const Ctx& P, int layer) {
    unsigned char* ws = P.ws(); const bf16_t* edge = (const bf16_t*)(ws + W_EDGE); bf16_t* act = (bf16_t*)(ws + R_UP);
    const float* cw = P.in(I_FFN_CW) + (size_t)layer * 3 * UPW; const float* cb = P.in(I_FFN_CB) + (size_t)layer * UPW;
    constexpr int NCG = DFF / 8, NT = M_TOK / 256;
    for (int it = blockIdx.x * 512 + ltid(); it < NT * 2 * NCG; it += gridDim.x * 512) {
        const int cgi = it % NCG, t2 = it / NCG, pm = t2 >> 1, which = t2 & 1, c0 = cgi * 8, row = pm * 256 + (which ? 255 : 0);
        const u32x4 zz = {0u, 0u, 0u, 0u}; u32x4 pg = zz, pv = zz, ng = zz, nv = zz;
        const bf16_t* e0 = edge + (size_t)(pm * 4) * 2 * DFF + c0;
        const int jc = which ? 3 : 0;
        const u32x4 cg_ = *(const u32x4*)(e0 + (size_t)jc * 2 * DFF), cv = *(const u32x4*)(e0 + (size_t)jc * 2 * DFF + DFF);
        if (which) { pg = *(const u32x4*)(e0 + (size_t)2 * 2 * DFF); pv = *(const u32x4*)(e0 + (size_t)2 * 2 * DFF + DFF);
            if (!tok_last(row)) { ng = *(const u32x4*)(e0 + (size_t)4 * 2 * DFF); nv = *(const u32x4*)(e0 + (size_t)4 * 2 * DFF + DFF); } }
        else { ng = *(const u32x4*)(e0 + (size_t)1 * 2 * DFF); nv = *(const u32x4*)(e0 + (size_t)1 * 2 * DFF + DFF);
            if (!tok_first(row)) { pg = *(const u32x4*)(e0 - (size_t)1 * 2 * DFF); pv = *(const u32x4*)(e0 - (size_t)1 * 2 * DFF + DFF); } }
        float a0[8], a1[8], a2[8], b0[8], b1[8], b2[8], o[8];
        unpack8(pg, a0); unpack8(cg_, a1); unpack8(ng, a2); unpack8(pv, b0); unpack8(cv, b1); unpack8(nv, b2);
#pragma unroll
        for (int hlf = 0; hlf < 2; ++hlf) {
            const f32x4 w0g = *(const f32x4*)(cw + c0 + 4 * hlf), w1g = *(const f32x4*)(cw + UPW + c0 + 4 * hlf), w2g = *(const f32x4*)(cw + 2 * UPW + c0 + 4 * hlf), bgv = *(const f32x4*)(cb + c0 + 4 * hlf);
            const f32x4 w0v = *(const f32x4*)(cw + DFF + c0 + 4 * hlf), w1v = *(const f32x4*)(cw + UPW + DFF + c0 + 4 * hlf), w2v = *(const f32x4*)(cw + 2 * UPW + DFF + c0 + 4 * hlf), bvv = *(const f32x4*)(cb + DFF + c0 + 4 * hlf);
#pragma unroll
            for (int j = 0; j < 4; ++j) { const int q = 4 * hlf + j; const float gt = bgv[j] + w0g[j] * a0[q] + w1g[j] * a1[q] + w2g[j] * a2[q]; const float vl = bvv[j] + w0v[j] * b0[q] + w1v[j] * b1[q] + w2v[j] * b2[q]; o[q] = siluf_(gt) * vl; } }
        *(u32x4*)(act + (size_t)row * DFF + c0) = pack8(o);
    }
}
template <class Epi> __device__ __forceinline__ void run_gemm(unsigned char* shm, const bf16_t* A, const bf16_t* Bt, int M, int N, int K, const Epi& E) {
    asm volatile("" : "+s"(M), "+s"(N), "+s"(K));
    pg8::Gemm g; g.A = A; g.Bt = Bt; g.M = M; g.N = N; g.K = K;
    pg8::StaticOrder S; S.init(M, N, (int)gridDim.x, (int)blockIdx.x);
    pg8::gemm_phase<Epi, pg8::StaticOrder, GEMM_ALIGN_EPI, GEMM_SP2>((PG8_LAS unsigned char*)shm, g, S, E);
}

__device__ __forceinline__ void tr_job(const float* W, int K, int N, int NP, const float* scale, bf16_t* dst, float* tile, bool permup) {
    int tid_ = ltid(); const int tid = tid_, nnb = NP / 64, nt = (K / 64) * nnb;
    for (int t = blockIdx.x; t < nt; t += gridDim.x) {
        const int kb = t / nnb, nb = t % nnb, k0 = kb * 64, n0 = nb * 64;
#pragma unroll
        for (int i = 0; i < 8; ++i) { const int kk = i * 8 + (tid >> 6), n = n0 + (tid & 63); float v = (n < N) ? W[(size_t)(k0 + kk) * N + n] : 0.f; if (scale) v *= scale[k0 + kk]; tile[kk * 65 + (tid & 63)] = v; }
        __syncthreads();
        { const int nn = tid >> 3, c = tid & 7; const float* s = tile + (8 * c) * 65 + nn;
          u32x4 o; o.x = pk2(s[0], s[65]); o.y = pk2(s[130], s[195]); o.z = pk2(s[260], s[325]); o.w = pk2(s[390], s[455]);
          int nrow = n0 + nn; if (permup) { const int hv = nrow >= DFF ? 1 : 0, chn = nrow - hv * DFF; nrow = (chn >> 7) * 256 + hv * 128 + (chn & 127); }
          *(u32x4*)(dst + (size_t)nrow * K + k0 + 8 * c) = o; }
        __syncthreads();
    }
}
__device__ __forceinline__ void prep_weights(const Ctx& P, int layer, unsigned char* shm) {
    unsigned char* ws = P.ws(); float* tile = (float*)shm; int tid_ = ltid(); const int tid = tid_, lane = tid & 63, wave = tid >> 6;
#pragma unroll 1
    for (int job = 0; job < 7; ++job) {
        const float* W; const float* sc = nullptr; int K, N, NP; bf16_t* dst;
        if (job == 0) { W = P.in(I_FFN_UP) + (size_t)layer * 1024 * UPW; K = 1024; N = UPW; NP = UPW; sc = P.in(I_NORM_FFN) + layer * 1024; dst = (bf16_t*)(ws + woff(W_WUP, layer)); }
        else if (job == 1) { W = P.in(I_FFN_DOWN) + (size_t)layer * DFF * 1024; K = DFF; N = 1024; NP = 1024; dst = (bf16_t*)(ws + woff(W_WDOWN, layer)); }
        else if (job == 2) { W = P.in(I_W_IN) + (size_t)layer * 1024 * INW; K = 1024; N = INW; NP = INP; sc = P.in(I_NORM_MIX) + layer * 1024; dst = (bf16_t*)(ws + woff(W_WIN, layer)); }
        else if (job == 3) { W = P.in(I_W_OUT) + (size_t)layer * 1024 * 1024; K = 1024; N = 1024; NP = 1024; dst = (bf16_t*)(ws + woff(W_WOUT, layer)); }
        else if (job == 4) { W = P.in(I_PLE_GATE) + (size_t)layer * 1024 * 1024; K = 1024; N = 1024; NP = 1024; sc = P.in(I_PLE_NORM) + layer * 1024; dst = (bf16_t*)(ws + woff(W_WG, layer)); }
        else if (job == 5) { W = P.in(I_PLE_PROJ) + (size_t)layer * 256 * 1024; K = 256; N = 1024; NP = 1024; dst = (bf16_t*)(ws + woff(W_WP, layer)); }
        else { W = P.in(I_S5_GLUW) + (size_t)layer * 256 * 256; K = 256; N = 256; NP = 256; dst = (bf16_t*)(ws + woff(W_GLU, layer)); }
        tr_job(W, K, N, NP, sc, dst, tile, job == 0);
    }
    const size_t gtid = (size_t)blockIdx.x * 512 + tid, gthreads = (size_t)gridDim.x * 512;
    {
        const float* src = P.in(I_SGU_W) + (size_t)layer * 65536; bf16_t* dst = (bf16_t*)(ws + woff(W_SGU, layer));
        for (size_t i = gtid; i < 65536 / 8; i += gthreads) { const f32x4 a = *(const f32x4*)(src + i * 8), b = *(const f32x4*)(src + i * 8 + 4);
            u32x4 o; o.x = pk2(a[0], a[1]); o.y = pk2(a[2], a[3]); o.z = pk2(b[0], b[1]); o.w = pk2(b[2], b[3]); *(u32x4*)(dst + i * 8) = o; }
    }
    {
        f32x2v* ab = (f32x2v*)(ws + woff(W_AB, layer)); f32x2v* abL = (f32x2v*)(ws + woff(W_ABL, layer)); bf16_t* bop = (bf16_t*)(ws + woff(W_BOP, layer)); bf16_t* cop = (bf16_t*)(ws + woff(W_COP, layer));
        for (int it = blockIdx.x; it < 32; it += gridDim.x) { const int k = it >> 4, g = it & 15, p = tid & 63, q = tid >> 6;
            const float step = expf(P.in(I_S5_LSTEP)[(layer * 2 + k) * 16 + g]);
            const float lr = P.in(I_S5_LRE)[((size_t)(layer * 2 + k) * 16 + g) * 64 + p], li = P.in(I_S5_LIM)[((size_t)(layer * 2 + k) * 16 + g) * 64 + p];
            const float mag = expf(lr * step); const float rev = li * step * 0.15915494309189535f; const float fr1 = rev - floorf(rev);
            const float abr = mag * __builtin_amdgcn_cosf(fr1), abi = mag * __builtin_amdgcn_sinf(fr1);
            const float den = lr * lr + li * li; const float f_re = ((abr - 1.0f) * lr + abi * li) / den, f_im = (abi * lr - (abr - 1.0f) * li) / den;
            if (q == 0) { f32x2v t; t.x = abr; t.y = abi; ab[(k * 16 + g) * 64 + p] = t;
                const float magL = expf(lr * step * 128.0f); const float revL = rev * 128.0f; const float frL = revL - floorf(revL);
                f32x2v tl; tl.x = magL * __builtin_amdgcn_cosf(frL); tl.y = magL * __builtin_amdgcn_sinf(frL); abL[(k * 16 + g) * 64 + p] = tl; }
#pragma unroll
            for (int cc = 0; cc < 2; ++cc) { const int c = 2 * q + cc;
                const float br = P.in(I_S5_BRE)[(((size_t)layer * 16 + g) * 64 + p) * 16 + c], bi = P.in(I_S5_BIM)[(((size_t)layer * 16 + g) * 64 + p) * 16 + c];
                bop[((size_t)(k * 16 + g) * 128 + p) * 16 + c] = f2bf(f_re * br - f_im * bi);
                bop[((size_t)(k * 16 + g) * 128 + 64 + p) * 16 + c] = f2bf(f_re * bi + f_im * br); }
            if (k == 0) {
#pragma unroll
                for (int j = 0; j < 4; ++j) { const int e = tid * 4 + j, i = e >> 7, kk = e & 127;
                    const float v = kk < 64 ? P.in(I_S5_CRE)[(((size_t)layer * 16 + g) * 16 + i) * 64 + kk] : -P.in(I_S5_CIM)[(((size_t)layer * 16 + g) * 16 + i) * 64 + (kk - 64)];
                    cop[((size_t)g * 16 + i) * 128 + kk] = f2bf(v); }
            }
        }
    }
}
__device__ __forceinline__ void pconv_phase(const Ctx& P, int layer) {
    unsigned char* ws = P.ws(); const int tid = ltid(); const size_t gtid = (size_t)blockIdx.x * 512 + tid, gthreads = (size_t)gridDim.x * 512;
    {
        bf16_t* dst = (bf16_t*)(ws + W_PBF);
        for (size_t i = gtid; i < (size_t)M_TOK * 32; i += gthreads) { const int row = (int)(i >> 5), cgi = (int)(i & 31);
            const float* src = row < MP ? P.in(I_PP) + ((size_t)layer * MP + row) * 256 : P.in(I_PS) + ((size_t)layer * (M_TOK - MP) + (row - MP)) * 256;
            const f32x4 a = *(const f32x4*)(src + cgi * 8), b = *(const f32x4*)(src + cgi * 8 + 4);
            u32x4 o; o.x = pk2(a[0], a[1]); o.y = pk2(a[2], a[3]); o.z = pk2(b[0], b[1]); o.w = pk2(b[2], b[3]); *(u32x4*)(dst + (size_t)row * 256 + cgi * 8) = o; }
    }
}
__device__ __forceinline__ void xinit_phase(const Ctx& P) {
    unsigned char* ws = P.ws(); const int tid = ltid(), lane = tid & 63, wave = tid >> 6;
    {
        bf16_t* xb = (bf16_t*)P.out(); float* part = (float*)(ws + W_PARTA);
        for (int row = blockIdx.x * 8 + wave; row < M_TOK; row += gridDim.x * 8) {
            const float* src = row < MP ? P.in(I_XP) + (size_t)row * 1024 : P.in(I_XS) + (size_t)(row - MP) * 1024;
            float ss = 0.f;
#pragma unroll
            for (int j = 0; j < 4; ++j) { const f32x4 v = ((const f32x4*)src)[lane + 64 * j];
                u32x2 w; w.x = pk2(v[0], v[1]); w.y = pk2(v[2], v[3]); ((u32x2*)(xb + (size_t)row * 1024))[lane + 64 * j] = w;
                ss += (v[0] * v[0] + v[1] * v[1]) + (v[2] * v[2] + v[3] * v[3]); }
            ss += __shfl_xor(ss, 1); ss += __shfl_xor(ss, 2);
            if ((lane & 3) == 0) part[(size_t)row * 16 + (lane >> 2)] = ss;
        }
    }
}

template <bool TR, int LG> __device__ __forceinline__ void conv_silu_tile(const bf16_t* proj, int t0, bool hp, bool hn, int cc0, const float* cw, const float* cb, bf16_t* dst) {
    constexpr int NG = 1 << LG;
    constexpr int NQ = TR ? (NG / 8) : 1, NL = TR ? 2 : 4;
    const int tid = ltid();
    u32x4 rc[2][NL], rp[2][NL], rn[2][NL];
#define CST_LOAD(q_, s_) do { const int cc_ = cc0 + (TR ? ((tid >> 6) + 8 * (q_)) : (tid & 15)) * 8; \
        _Pragma("unroll") for (int i_ = 0; i_ < NL; ++i_) { const int l_ = TR ? ((tid & 63) + 64 * i_) : ((tid >> 4) + 32 * i_); const bf16_t* base_ = proj + (size_t)(t0 + l_) * INW + O_XBC + cc_; \
            const bool vp_ = (l_ > 0) | hp, vn_ = (l_ < 127) | hn; const u32x4 zz_ = {0u, 0u, 0u, 0u}; \
            rc[s_][i_] = *(const u32x4*)base_; const u32x4 tp_ = *(const u32x4*)(base_ - (vp_ ? INW : 0)), tn_ = *(const u32x4*)(base_ + (vn_ ? INW : 0)); rp[s_][i_] = vp_ ? tp_ : zz_; rn[s_][i_] = vn_ ? tn_ : zz_; } } while (0)
    CST_LOAD(0, 0);
#pragma unroll
    for (int q = 0; q < NQ; ++q) {
        const int cgi = TR ? ((tid >> 6) + 8 * q) : (tid & 15);
        const int cc = cc0 + cgi * 8;
        float w0[8], w1[8], w2[8], bb[8];
#pragma unroll
        for (int hlf = 0; hlf < 2; ++hlf) { const f32x4 a = *(const f32x4*)(cw + cc + 4 * hlf), b = *(const f32x4*)(cw + 1024 + cc + 4 * hlf), c = *(const f32x4*)(cw + 2048 + cc + 4 * hlf), d = *(const f32x4*)(cb + cc + 4 * hlf);
#pragma unroll
            for (int j = 0; j < 4; ++j) { w0[4 * hlf + j] = a[j]; w1[4 * hlf + j] = b[j]; w2[4 * hlf + j] = c[j]; bb[4 * hlf + j] = d[j]; } }
        if (q + 1 < NQ) CST_LOAD(q + 1, (q + 1) & 1);
#pragma unroll
        for (int i = 0; i < NL; ++i) {
            const int l = TR ? ((tid & 63) + 64 * i) : ((tid >> 4) + 32 * i);
            float xp[8], xc[8], xn[8], o[8];
            unpack8(rp[q & 1][i], xp); unpack8(rc[q & 1][i], xc); unpack8(rn[q & 1][i], xn);
#pragma unroll
            for (int j = 0; j < 8; ++j) o[j] = siluf_(bb[j] + w0[j] * xp[j] + w1[j] * xc[j] + w2[j] * xn[j]);
            if (TR) {
#pragma unroll
                for (int j = 0; j < 8; ++j) dst[(cgi * 8 + j) * 136 + l] = f2bf(o[j]);
            } else { *(u32x4*)(dst + l * 136 + cgi * 8) = pack8(o); }
        }
        if (q + 1 < NQ) asm volatile("" ::: "memory");
    }
#undef CST_LOAD
}

struct XhRegs { u32x4 rc[2], rp[2], rn[2]; };
__device__ __forceinline__ void xh_load(XhRegs& R, const bf16_t* proj, int t0, bool hp, bool hn, int cc0, int tid) {
    const int cc = cc0 + (tid >> 6) * 8;
#pragma unroll
    for (int i = 0; i < 2; ++i) { const int l = (tid & 63) + 64 * i; const bf16_t* base = proj + (size_t)(t0 + l) * INW + O_XBC + cc;
        const bool vp = (l > 0) | hp, vn = (l < 127) | hn; const u32x4 zz = {0u, 0u, 0u, 0u};
        R.rc[i] = *(const u32x4*)base; const u32x4 tp = *(const u32x4*)(base - (vp ? INW : 0)), tn = *(const u32x4*)(base + (vn ? INW : 0)); R.rp[i] = vp ? tp : zz; R.rn[i] = vn ? tn : zz; }
}
__device__ __forceinline__ void xh_store(const XhRegs& R, int cc0, const float* cw, const float* cb, bf16_t* dst, int tid) {
    const int cgi = tid >> 6, cc = cc0 + cgi * 8;
    float w0[8], w1[8], w2[8], bb[8];
#pragma unroll
    for (int hlf = 0; hlf < 2; ++hlf) { const f32x4 a = *(const f32x4*)(cw + cc + 4 * hlf), b = *(const f32x4*)(cw + 1024 + cc + 4 * hlf), c = *(const f32x4*)(cw + 2048 + cc + 4 * hlf), d = *(const f32x4*)(cb + cc + 4 * hlf);
#pragma unroll
        for (int j = 0; j < 4; ++j) { w0[4 * hlf + j] = a[j]; w1[4 * hlf + j] = b[j]; w2[4 * hlf + j] = c[j]; bb[4 * hlf + j] = d[j]; } }
#pragma unroll
    for (int i = 0; i < 2; ++i) { const int l = (tid & 63) + 64 * i; float xp[8], xc[8], xn[8];
        unpack8(R.rp[i], xp); unpack8(R.rc[i], xc); unpack8(R.rn[i], xn);
#pragma unroll
        for (int j = 0; j < 8; ++j) dst[(cgi * 8 + j) * 136 + l] = f2bf(siluf_(bb[j] + w0[j] * xp[j] + w1[j] * xc[j] + w2[j] * xn[j])); }
}

__device__ __forceinline__ void ssd_s1_item(const Ctx& P, int layer, int item, unsigned char* shm) {
    int tid_ = ltid(); const int tid = tid_, lane = tid & 63, wave = tid >> 6, fr = lane & 15, fq = lane >> 4;
    const int chunk = item >> 1, g = item & 1, t0 = chunk * 128;
    const bool hp = !tok_first(t0), hn = !tok_last(t0 + 127);
    unsigned char* ws = P.ws(); const bf16_t* proj = (const bf16_t*)(ws + R_PROJ); const float* dtb = (const float*)(ws + W_DT);
    bf16_t* Bt = (bf16_t*)shm; bf16_t* xT = (bf16_t*)(shm + 34816); float* WGT = (float*)(shm + 104448);
    const float* cw = P.in(I_SSD_CW) + (size_t)layer * 3 * 1024; const float* cb = P.in(I_SSD_CB) + (size_t)layer * 1024;
    conv_silu_tile<true, 4>(proj, t0, hp, hn, 512 + g * 128, cw, cb, Bt);
    conv_silu_tile<true, 5>(proj, t0, hp, hn, g * 256, cw, cb, xT);
    const int hh = wave & 3, dir = wave >> 2, h = g * 4 + hh;
    {
        const float bias = P.in(I_SSD_DTB)[(layer * 2 + dir) * 8 + h], a = -expf(P.in(I_SSD_ALOG)[(layer * 2 + dir) * 8 + h]);
        const int l0 = 2 * lane;
        const float d0 = softplusf_(dtb[(size_t)(t0 + l0) * 16 + dir * 8 + h] + bias), d1 = softplusf_(dtb[(size_t)(t0 + l0 + 1) * 16 + dir * 8 + h] + bias);
        const float a0 = d0 * a, a1 = d1 * a;
        const float incl = wave_incl_scan(a0 + a1, lane); const float total = __shfl(incl, 63);
        const float cs1 = incl, cs0 = incl - a1;
        float w0, w1;
        if (dir == 0) { w0 = d0 * __expf(total - cs0); w1 = d1 * __expf(total - cs1); }
        else { w0 = d0 * __expf(cs0 - a0); w1 = d1 * __expf(cs0); }
        WGT[wave * 128 + l0] = w0; WGT[wave * 128 + l0 + 1] = w1;
        if (lane == 0) ((float*)(ws + W_DECAY))[(chunk * 2 + dir) * 8 + h] = __expf(total);
    }
    __syncthreads();
    f32x4 acc[4][8];
#pragma unroll
    for (int i = 0; i < 4; ++i)
#pragma unroll
        for (int j = 0; j < 8; ++j) acc[i][j] = (f32x4){0.f, 0.f, 0.f, 0.f};
#pragma unroll
    for (int ks = 0; ks < 4; ++ks) {
        const f32x4 wa = *(const f32x4*)(WGT + wave * 128 + ks * 32 + fq * 8), wb = *(const f32x4*)(WGT + wave * 128 + ks * 32 + fq * 8 + 4);
        bf16x8 af[4];
#pragma unroll
        for (int i = 0; i < 4; ++i) { const u32x4 r = *(const u32x4*)(xT + (hh * 64 + 16 * i + fr) * 136 + ks * 32 + fq * 8);
            u32x4 s; s.x = pk2(bflo(r.x) * wa[0], bfhi(r.x) * wa[1]); s.y = pk2(bflo(r.y) * wa[2], bfhi(r.y) * wa[3]); s.z = pk2(bflo(r.z) * wb[0], bfhi(r.z) * wb[1]); s.w = pk2(bflo(r.w) * wb[2], bfhi(r.w) * wb[3]);
            af[i] = __builtin_bit_cast(bf16x8, s); }
#pragma unroll
        for (int j = 0; j < 8; ++j) { const bf16x8 bfj = *(const bf16x8*)(Bt + prow(j, fr) * 136 + ks * 32 + fq * 8);
#pragma unroll
            for (int i = 0; i < 4; ++i) acc[i][j] = MFMA32(bfj, af[i], acc[i][j]); }
    }
    bf16_t* st = (bf16_t*)(ws + R_STATES) + ((size_t)(chunk * 2 + dir) * 8 + h) * 8192;
#pragma unroll
    for (int i = 0; i < 4; ++i)
#pragma unroll
        for (int jj = 0; jj < 4; ++jj) { u32x4 w; w.x = pk2(acc[i][2 * jj][0], acc[i][2 * jj][1]); w.y = pk2(acc[i][2 * jj][2], acc[i][2 * jj][3]); w.z = pk2(acc[i][2 * jj + 1][0], acc[i][2 * jj + 1][1]); w.w = pk2(acc[i][2 * jj + 1][2], acc[i][2 * jj + 1][3]);
            *(u32x4*)(st + (16 * i + fr) * 128 + 32 * jj + 8 * fq) = w; }
    __syncthreads();
}

__device__ __forceinline__ void ssd_scan_item(const Ctx& P, int item) {
    int tid_ = ltid(); const int tid = tid_; unsigned char* ws = P.ws();
    const int sp = item >> 5, rem = item & 31; const int seq = sp < 2 ? 16 + sp : sp - 2; const int dir = rem >> 4, h = (rem >> 1) & 7, ps = rem & 1;
    const int nC = seq < 16 ? 16 : 64, cbase = seq < 16 ? seq * 16 : 256 + (seq - 16) * 64;
    const int p = ps * 32 + (tid >> 4), ng = tid & 15;
    bf16_t* states = (bf16_t*)(ws + R_STATES); const float* decay = (const float*)(ws + W_DECAY);
    float run[8];
#pragma unroll
    for (int j = 0; j < 8; ++j) run[j] = 0.f;
    {
        long sstride = dir == 0 ? (long)(2 * 8 * 8192) : -(long)(2 * 8 * 8192);
        int dstride = dir == 0 ? 16 : -16;
        asm volatile("" : "+v"(sstride), "+v"(dstride));
        const int cfirst = cbase + (dir == 0 ? 0 : nC - 1);
        bf16_t* a0 = states + ((size_t)(cfirst * 2 + dir) * 8 + h) * 8192 + p * 128 + ng * 8;
        const float* d0 = decay + (cfirst * 2 + dir) * 8 + h;
        for (int c8 = 0; c8 < nC; c8 += 8) {
            u32x4 v[8]; float dc[8];
#pragma unroll
            for (int i = 0; i < 8; ++i) { v[i] = *(const u32x4*)(a0 + i * sstride); dc[i] = d0[i * dstride]; }
#pragma unroll
            for (int i = 0; i < 8; ++i) { float sv[8]; unpack8(v[i], sv); if (P.rep == 0) *(u32x4*)(a0 + i * sstride) = pack8(run);
#pragma unroll
                for (int j = 0; j < 8; ++j) run[j] = run[j] * dc[i] + sv[j]; }
            a0 += 8 * sstride; d0 += 8 * dstride;
        }
    }
}

#define S3_PRELOAD(hq) do { xh_load(XR, proj, t0, hp, hn, g * 256 + (hq) * 64, tid); \
        const bf16_t* sf_ = states + ((size_t)(chunk * 2 + 0) * 8 + g * 4 + (hq)) * 8192; const bf16_t* sb_ = states + ((size_t)(chunk * 2 + 1) * 8 + g * 4 + (hq)) * 8192; \
        _Pragma("unroll") for (int i_ = 0; i_ < 2; ++i_) { const int it_ = tid + 512 * i_, p_ = it_ >> 4, c_ = it_ & 15; hfr[i_] = *(const u32x4*)(sf_ + p_ * 128 + c_ * 8); hbr[i_] = *(const u32x4*)(sb_ + p_ * 128 + c_ * 8); } } while (0)
__device__ __forceinline__ void ssd_s3_item(const Ctx& P, int layer, int item, unsigned char* shm) {
    int tid_ = ltid(); const int tid = tid_, lane = tid & 63, wave = tid >> 6, fr = lane & 15, fq = lane >> 4;
    const int chunk = item >> 1, g = item & 1, t0 = chunk * 128;
    const bool hp = !tok_first(t0), hn = !tok_last(t0 + 127);
    unsigned char* ws = P.ws(); const bf16_t* proj = (const bf16_t*)(ws + R_PROJ); const float* dtb = (const float*)(ws + W_DT);
    bf16_t* Cn = (bf16_t*)shm; bf16_t* BW = (bf16_t*)(shm + 34816); bf16_t* xTh = (bf16_t*)(shm + 69632); bf16_t* Hf = (bf16_t*)(shm + 87040); bf16_t* Hb = (bf16_t*)(shm + 104448);
    float* CSF = (float*)(shm + 121856); float* RCS = (float*)(shm + 123904); float* DTF = (float*)(shm + 125952); float* DTB = (float*)(shm + 128000);
    const float* cw = P.in(I_SSD_CW) + (size_t)layer * 3 * 1024; const float* cb = P.in(I_SSD_CB) + (size_t)layer * 1024;
    const bf16_t* states = (const bf16_t*)(ws + R_STATES);
    XhRegs XR; u32x4 hfr[2], hbr[2];
    S3_PRELOAD(0);
    conv_silu_tile<false, 4>(proj, t0, hp, hn, 512 + 256 + g * 128, cw, cb, Cn);
    conv_silu_tile<false, 4>(proj, t0, hp, hn, 512 + g * 128, cw, cb, BW);
    {
        const int hh = wave & 3, dir = wave >> 2, h = g * 4 + hh;
        const float bias = P.in(I_SSD_DTB)[(layer * 2 + dir) * 8 + h], a = -expf(P.in(I_SSD_ALOG)[(layer * 2 + dir) * 8 + h]);
        const int l0 = 2 * lane;
        const float d0 = softplusf_(dtb[(size_t)(t0 + l0) * 16 + dir * 8 + h] + bias), d1 = softplusf_(dtb[(size_t)(t0 + l0 + 1) * 16 + dir * 8 + h] + bias);
        const float a0 = d0 * a, a1 = d1 * a;
        const float incl = wave_incl_scan(a0 + a1, lane); const float total = __shfl(incl, 63);
        const float cs1 = incl, cs0 = incl - a1;
        if (dir == 0) { CSF[hh * 128 + l0] = cs0; CSF[hh * 128 + l0 + 1] = cs1; DTF[hh * 128 + l0] = d0; DTF[hh * 128 + l0 + 1] = d1; }
        else { RCS[hh * 128 + l0] = total - (cs0 - a0); RCS[hh * 128 + l0 + 1] = total - cs0; DTB[hh * 128 + l0] = d0; DTB[hh * 128 + l0 + 1] = d1; }
    }
    __syncthreads();
    const int l = 16 * wave + fr;
    f32x4 cbm[8];
#pragma unroll
    for (int j = 0; j < 8; ++j) cbm[j] = (f32x4){0.f, 0.f, 0.f, 0.f};
#pragma unroll
    for (int ks = 0; ks < 4; ++ks) { const bf16x8 sec = *(const bf16x8*)(Cn + l * 136 + ks * 32 + fq * 8);
#pragma unroll
        for (int j = 0; j < 8; ++j) { const bf16x8 fst = *(const bf16x8*)(BW + (16 * j + fr) * 136 + ks * 32 + fq * 8); cbm[j] = MFMA32(fst, sec, cbm[j]); } }
    __syncthreads();
    float ssq = 0.f;
    bf16_t* mix = (bf16_t*)(ws + R_MIX);
#pragma unroll 1
    for (int hh = 0; hh < 4; ++hh) {
        const int h = g * 4 + hh;
        xh_store(XR, g * 256 + hh * 64, cw, cb, xTh, tid);
#pragma unroll
        for (int i = 0; i < 2; ++i) { const int it = tid + 512 * i, p = it >> 4, c = it & 15; *(u32x4*)(Hf + p * 136 + c * 8) = hfr[i]; *(u32x4*)(Hb + p * 136 + c * 8) = hbr[i]; }
        {
            int lq = l; asm volatile("" : "+v"(lq));
            const float cfl = CSF[hh * 128 + l], rcl = RCS[hh * 128 + l];
#pragma unroll
            for (int j = 0; j < 8; ++j) { float wv[4];
                const int s0 = 16 * j + 4 * fq;
                const f32x4 csf4 = *(const f32x4*)(CSF + hh * 128 + s0), dtf4 = *(const f32x4*)(DTF + hh * 128 + s0), rcs4 = *(const f32x4*)(RCS + hh * 128 + s0), dtb4 = *(const f32x4*)(DTB + hh * 128 + s0);
#pragma unroll
                for (int r = 0; r < 4; ++r) { const int s = s0 + r;
                    const float ef = (s <= lq) ? __expf(cfl - csf4[r]) * dtf4[r] : 0.f;
                    const float eb = (s >= lq) ? __expf(rcl - rcs4[r]) * dtb4[r] : 0.f;
                    wv[r] = cbm[j][r] * (ef + eb); }
                u32x2 w; w.x = pk2(wv[0], wv[1]); w.y = pk2(wv[2], wv[3]); *(u32x2*)(BW + l * 136 + 16 * j + 4 * fq) = w; }
        }
        __syncthreads();
        if (hh < 3) S3_PRELOAD(hh + 1);
        f32x4 ya[4], tf[4], tb[4];
#pragma unroll
        for (int j = 0; j < 4; ++j) { ya[j] = (f32x4){0.f, 0.f, 0.f, 0.f}; tf[j] = ya[j]; tb[j] = ya[j]; }
#pragma unroll
        for (int ks = 0; ks < 4; ++ks) {
            const bf16x8 secC = *(const bf16x8*)(Cn + l * 136 + ks * 32 + fq * 8), secW = *(const bf16x8*)(BW + l * 136 + ks * 32 + fq * 8);
#pragma unroll
            for (int j = 0; j < 4; ++j) {
                const bf16x8 f1 = *(const bf16x8*)(Hf + prow(j, fr) * 136 + ks * 32 + fq * 8), f2 = *(const bf16x8*)(Hb + prow(j, fr) * 136 + ks * 32 + fq * 8), f3 = *(const bf16x8*)(xTh + prow(j, fr) * 136 + ks * 32 + fq * 8);
                tf[j] = MFMA32(f1, secC, tf[j]); tb[j] = MFMA32(f2, secC, tb[j]); ya[j] = MFMA32(f3, secW, ya[j]); }
        }
        {
            const float ef = __expf(CSF[hh * 128 + l]), eb = __expf(RCS[hh * 128 + l]), dsk = P.in(I_SSD_D)[layer * 8 + h];
#pragma unroll
            for (int jj = 0; jj < 2; ++jj) { const int p0 = 32 * jj + 8 * fq;
                float z[8], yv[8]; unpack8(*(const u32x4*)(proj + (size_t)(t0 + l) * INW + h * 64 + p0), z);
#pragma unroll
                for (int e = 0; e < 8; ++e) { const int j = 2 * jj + (e >> 2), r = e & 3; const float xs = bf2f(xTh[(p0 + e) * 136 + l]);
                    const float y = ya[j][r] + tf[j][r] * ef + tb[j][r] * eb + dsk * xs; yv[e] = y * siluf_(z[e]); ssq += yv[e] * yv[e]; }
                *(u32x4*)(mix + (size_t)(t0 + l) * 1024 + h * 64 + p0) = pack8(yv); }
        }
        __syncthreads();
    }
    ssq += __shfl_xor(ssq, 16); ssq += __shfl_xor(ssq, 32);
    if (fq == 0) ((float*)(ws + W_SSQ))[(size_t)(t0 + l) * 2 + g] = ssq;
}

template <bool FULL> __device__ __forceinline__ void s5_item(const Ctx& P, int layer, int item, unsigned char* shm) {
    int tid_ = ltid(); const int tid = tid_, lane = tid & 63, wave = tid >> 6, fr = lane & 15, fq = lane >> 4;
    const int sq = item >> 2, k = (item >> 1) & 1, g = (item & 1) * 8 + wave;
    unsigned char* ws = P.ws(); const bf16_t* proj = (const bf16_t*)(ws + R_PROJ);
    const f32x2v* ab = (const f32x2v*)(ws + woff(W_AB, layer)); const bf16_t* bop = (const bf16_t*)(ws + woff(W_BOP, layer)); const bf16_t* cop = (const bf16_t*)(ws + woff(W_COP, layer));
    bf16_t* S = (bf16_t*)(shm + wave * 4352);
    float are[4], aim[4], sre[4], sim[4]; bf16x4 bre[4], bim[4]; bf16x8 cf[4];
    const int seg = sq * 4 + fq;
#pragma unroll
    for (int j = 0; j < 4; ++j) { const f32x2v t = ab[(k * 16 + g) * 64 + 16 * j + fr]; are[j] = t.x; aim[j] = t.y;
        bre[j] = *(const bf16x4*)(bop + ((size_t)(k * 16 + g) * 128 + 16 * j + fr) * 16 + fq * 4);
        bim[j] = *(const bf16x4*)(bop + ((size_t)(k * 16 + g) * 128 + 64 + 16 * j + fr) * 16 + fq * 4);
        if (FULL) { cf[j] = *(const bf16x8*)(cop + ((size_t)g * 16 + fr) * 128 + j * 32 + fq * 8);
            const f32x2v hi = ((const f32x2v*)(ws + W_HIN))[((size_t)(seg * 2 + k) * 16 + g) * 64 + 16 * j + fr]; sre[j] = hi.x; sim[j] = hi.y; }
        else { sre[j] = 0.f; sim[j] = 0.f; } }
    const int qa = fr >> 2, ra = fr & 3;
    const bf16_t* abase = proj + O_S5 + g * 16 + fq * 4;
    const int tokA0 = (sq * 4 + qa) * 128;
    bf16_t* yb = (bf16_t*)(ws + R_S5Y) + (size_t)k * M_TOK * 256 + g * 16 + fr;
    bf16x4 afr = *(const bf16x4*)(abase + (size_t)(tokA0 + (k == 0 ? ra : 127 - ra)) * INW);
    for (int tb = 0; tb < 32; ++tb) {
        const bf16x4 acur = afr;
        if (tb < 31) { const int tau = (tb + 1) * 4 + ra; afr = *(const bf16x4*)(abase + (size_t)(tokA0 + (k == 0 ? tau : 127 - tau)) * INW); }
        f32x4 ure[4], uim[4];
#pragma unroll
        for (int j = 0; j < 4; ++j) { ure[j] = MFMA16(acur, bre[j], ((f32x4){0.f, 0.f, 0.f, 0.f})); uim[j] = MFMA16(acur, bim[j], ((f32x4){0.f, 0.f, 0.f, 0.f})); }
#pragma unroll
        for (int r = 0; r < 4; ++r)
#pragma unroll
            for (int j = 0; j < 4; ++j) { const float nre = are[j] * sre[j] - aim[j] * sim[j] + ure[j][r], nim = are[j] * sim[j] + aim[j] * sre[j] + uim[j][r]; sre[j] = nre; sim[j] = nim;
                if (FULL) { S[(4 * fq + r) * 136 + 16 * j + fr] = f2bf(nre); S[(4 * fq + r) * 136 + 64 + 16 * j + fr] = f2bf(nim); } }
        if (FULL) {
            WAVE_LDS_FENCE();
            f32x4 ya = (f32x4){0.f, 0.f, 0.f, 0.f};
#pragma unroll
            for (int ks = 0; ks < 4; ++ks) { const bf16x8 a2 = *(const bf16x8*)(S + fr * 136 + ks * 32 + fq * 8); ya = MFMA32(a2, cf[ks], ya); }
            WAVE_LDS_FENCE();
#pragma unroll
            for (int r = 0; r < 4; ++r) { const int tau = tb * 4 + r; const int tok = seg * 128 + (k == 0 ? tau : 127 - tau); yb[(size_t)tok * 256] = f2bf(ya[r]); }
        }
    }
    if (!FULL) {
        f32x2v* hl = (f32x2v*)(ws + W_HLOC);
#pragma unroll
        for (int j = 0; j < 4; ++j) { f32x2v t; t.x = sre[j]; t.y = sim[j]; hl[((size_t)(seg * 2 + k) * 16 + g) * 64 + 16 * j + fr] = t; }
    }
}
__device__ __forceinline__ void s5_carry(const Ctx& P, int layer) {
    unsigned char* ws = P.ws(); const f32x2v* abL = (const f32x2v*)(ws + woff(W_ABL, layer)); const f32x2v* hl = (const f32x2v*)(ws + W_HLOC); f32x2v* hin = (f32x2v*)(ws + W_HIN);
    for (int idx = blockIdx.x * 512 + ltid(); idx < 18 * 2048; idx += gridDim.x * 512) {
        const int p = idx & 63, g = (idx >> 6) & 15, k = (idx >> 10) & 1, seq = idx >> 11;
        const int nS = seq < 16 ? 16 : 64, sbase = seq < 16 ? seq * 16 : 256 + (seq - 16) * 64;
        const f32x2v a = abL[(k * 16 + g) * 64 + p]; float rr = 0.f, ri = 0.f;
        for (int s8 = 0; s8 < nS; s8 += 8) {
            f32x2v v[8]; size_t o[8];
#pragma unroll
            for (int i = 0; i < 8; ++i) { const int sg = sbase + (k == 0 ? s8 + i : nS - 1 - (s8 + i)); o[i] = ((size_t)(sg * 2 + k) * 16 + g) * 64 + p; v[i] = hl[o[i]]; }
#pragma unroll
            for (int i = 0; i < 8; ++i) { f32x2v t; t.x = rr; t.y = ri; hin[o[i]] = t;
                const float nr = a.x * rr - a.y * ri + v[i].x, ni = a.x * ri + a.y * rr + v[i].y; rr = nr; ri = ni; }
        }
    }
}

__device__ __forceinline__ void sgu_item(const Ctx& P, int layer, int chunk, unsigned char* shm) {
    int tid_ = ltid(); const int tid = tid_, lane = tid & 63, wave = tid >> 6, fr = lane & 15, fq = lane >> 4, t0 = chunk * 128;
    unsigned char* ws = P.ws(); const bf16_t* proj = (const bf16_t*)(ws + R_PROJ); bf16_t* vT = (bf16_t*)shm;
    {
        const int l = tid >> 2, part = tid & 3; const bf16_t* src = proj + (size_t)(t0 + l) * INW + O_SGU + 256 + part * 64;
        float v[64]; float s = 0.f;
#pragma unroll
        for (int i = 0; i < 8; ++i) { float t[8]; unpack8(*(const u32x4*)(src + i * 8), t);
#pragma unroll
            for (int j = 0; j < 8; ++j) { v[i * 8 + j] = geluf_(t[j]); s += v[i * 8 + j]; } }
        s += __shfl_xor(s, 1); s += __shfl_xor(s, 2); const float mean = s * (1.0f / 256.0f); float q = 0.f;
#pragma unroll
        for (int i = 0; i < 64; ++i) { v[i] -= mean; q += v[i] * v[i]; }
        q += __shfl_xor(q, 1); q += __shfl_xor(q, 2); const float rstd = rsqrtf(q * (1.0f / 256.0f) + 1e-5f);
        const float* nw = P.in(I_SGU_NW) + layer * 256 + part * 64; const float* nb = P.in(I_SGU_NB) + layer * 256 + part * 64;
#pragma unroll
        for (int i = 0; i < 64; ++i) vT[(part * 64 + i) * 136 + l] = f2bf(v[i] * rstd * nw[i] + nb[i]);
    }
    __syncthreads();
    const int t = 16 * wave + fr; const bf16_t* Wsg = (const bf16_t*)(ws + woff(W_SGU, layer));
    f32x4 acc[4][4];
#pragma unroll
    for (int h = 0; h < 4; ++h)
#pragma unroll
        for (int j = 0; j < 4; ++j) acc[h][j] = (f32x4){0.f, 0.f, 0.f, 0.f};
#pragma unroll
    for (int h = 0; h < 4; ++h)
#pragma unroll
        for (int ks = 0; ks < 4; ++ks) { const bf16x8 sec = *(const bf16x8*)(Wsg + ((size_t)h * 128 + t) * 128 + ks * 32 + fq * 8);
#pragma unroll
            for (int j = 0; j < 4; ++j) { const bf16x8 fst = *(const bf16x8*)(vT + (h * 64 + 16 * j + fr) * 136 + ks * 32 + fq * 8); acc[h][j] = MFMA32(fst, sec, acc[h][j]); } }
    float ss = 0.f;
#pragma unroll
    for (int h = 0; h < 4; ++h) { const float bs = P.in(I_SGU_B)[(layer * 4 + h) * 128 + t];
#pragma unroll
        for (int j = 0; j < 4; ++j) { const int ch = h * 64 + 16 * j + 4 * fq; const u32x2 uw = *(const u32x2*)(proj + (size_t)(t0 + t) * INW + O_SGU + ch);
            const float u0 = geluf_(bflo(uw.x)), u1 = geluf_(bfhi(uw.x)), u2 = geluf_(bflo(uw.y)), u3 = geluf_(bfhi(uw.y));
            f32x4 o; o[0] = u0 * (acc[h][j][0] + bs); o[1] = u1 * (acc[h][j][1] + bs); o[2] = u2 * (acc[h][j][2] + bs); o[3] = u3 * (acc[h][j][3] + bs);
            acc[h][j] = o; ss += (o[0] * o[0] + o[1] * o[1]) + (o[2] * o[2] + o[3] * o[3]); } }
    ss += __shfl_xor(ss, 16); ss += __shfl_xor(ss, 32);
    const float rstd = rsqrtf(ss * (1.0f / 256.0f) + 1e-6f); bf16_t* mix = (bf16_t*)(ws + R_MIX); const float* onw = P.in(I_SGU_ONORM) + layer * 256;
#pragma unroll
    for (int h = 0; h < 4; ++h)
#pragma unroll
        for (int j = 0; j < 4; ++j) { const int ch = h * 64 + 16 * j + 4 * fq; const f32x4 w4 = *(const f32x4*)(onw + ch); const f32x4 o = acc[h][j];
            u32x2 w; w.x = pk2(o[0] * rstd * w4[0], o[1] * rstd * w4[1]); w.y = pk2(o[2] * rstd * w4[2], o[3] * rstd * w4[3]); *(u32x2*)(mix + (size_t)(t0 + t) * 1024 + 768 + ch) = w; }
    __syncthreads();
}

__device__ __forceinline__ void finalize_item(const Ctx& P, int layer, int tile, unsigned char* shm) {
    int tid_ = ltid(); const int tid = tid_, lane = tid & 63, wave = tid >> 6, fr = lane & 15, fq = lane >> 4, t0 = tile * 128;
    unsigned char* ws = P.ws(); const bf16_t* proj = (const bf16_t*)(ws + R_PROJ); bf16_t* mix = (bf16_t*)(ws + R_MIX);
    {
        const float* ssq = (const float*)(ws + W_SSQ); const float* nw = P.in(I_SSD_NORM) + layer * 512;
#pragma unroll 4
        for (int i = 0; i < 16; ++i) { const int it = tid + 512 * i, l = it >> 6, cgi = it & 63;
            const float rstd = rsqrtf((ssq[(size_t)(t0 + l) * 2] + ssq[(size_t)(t0 + l) * 2 + 1]) * (1.0f / 512.0f) + 1e-6f);
            bf16_t* ptr = mix + (size_t)(t0 + l) * 1024 + cgi * 8; float v[8]; unpack8(*(const u32x4*)ptr, v);
            const f32x4 wa = *(const f32x4*)(nw + cgi * 8), wb = *(const f32x4*)(nw + cgi * 8 + 4);
            v[0] *= rstd * wa[0]; v[1] *= rstd * wa[1]; v[2] *= rstd * wa[2]; v[3] *= rstd * wa[3]; v[4] *= rstd * wb[0]; v[5] *= rstd * wb[1]; v[6] *= rstd * wb[2]; v[7] *= rstd * wb[3];
            if (P.rep == 0) *(u32x4*)ptr = pack8(v); }
    }
    bf16_t* Yg = (bf16_t*)shm;
    {
        const bf16_t* yf = (const bf16_t*)(ws + R_S5Y); const bf16_t* ybk = yf + (size_t)M_TOK * 256; const float* dsk = P.in(I_S5_D) + layer * 256;
#pragma unroll 2
        for (int i = 0; i < 8; ++i) { const int it = tid + 512 * i, l = it >> 5, cgi = it & 31;
            float u[8], a[8], b[8], o[8]; unpack8(*(const u32x4*)(proj + (size_t)(t0 + l) * INW + O_S5 + cgi * 8), u);
            unpack8(*(const u32x4*)(yf + (size_t)(t0 + l) * 256 + cgi * 8), a); unpack8(*(const u32x4*)(ybk + (size_t)(t0 + l) * 256 + cgi * 8), b);
            const f32x4 da = *(const f32x4*)(dsk + cgi * 8), db = *(const f32x4*)(dsk + cgi * 8 + 4);
#pragma unroll
            for (int j = 0; j < 8; ++j) o[j] = geluf_(u[j] * (j < 4 ? da[j & 3] : db[j & 3]) + a[j] + b[j]);
            *(u32x4*)(Yg + l * 264 + cgi * 8) = pack8(o); }
    }
    __syncthreads();
    const int t = 16 * wave + fr; const bf16_t* glut = (const bf16_t*)(ws + woff(W_GLU, layer));
    f32x4 acc[16];
#pragma unroll
    for (int j = 0; j < 16; ++j) acc[j] = (f32x4){0.f, 0.f, 0.f, 0.f};
#pragma unroll 1
    for (int ks = 0; ks < 8; ++ks) { const bf16x8 sec = *(const bf16x8*)(Yg + t * 264 + ks * 32 + fq * 8);
#pragma unroll
        for (int j = 0; j < 16; ++j) { const bf16x8 fst = *(const bf16x8*)(glut + (size_t)(16 * j + fr) * 256 + ks * 32 + fq * 8); acc[j] = MFMA32(fst, sec, acc[j]); } }
    float ss = 0.f; const float* gb = P.in(I_S5_GLUB) + layer * 256;
#pragma unroll
    for (int j = 0; j < 16; ++j) { const int n0 = 16 * j + 4 * fq; const u32x2 yw = *(const u32x2*)(Yg + t * 264 + n0); const f32x4 b4 = *(const f32x4*)(gb + n0);
        f32x4 o; o[0] = bflo(yw.x) * sigmoidf_(acc[j][0] + b4[0]); o[1] = bfhi(yw.x) * sigmoidf_(acc[j][1] + b4[1]); o[2] = bflo(yw.y) * sigmoidf_(acc[j][2] + b4[2]); o[3] = bfhi(yw.y) * sigmoidf_(acc[j][3] + b4[3]);
        acc[j] = o; ss += (o[0] * o[0] + o[1] * o[1]) + (o[2] * o[2] + o[3] * o[3]); }
    ss += __shfl_xor(ss, 16); ss += __shfl_xor(ss, 32);
    const float rstd = rsqrtf(ss * (1.0f / 256.0f) + 1e-6f); const float* onw = P.in(I_S5_ONORM) + layer * 256;
#pragma unroll
    for (int j = 0; j < 16; ++j) { const int n0 = 16 * j + 4 * fq; const f32x4 w4 = *(const f32x4*)(onw + n0); const f32x4 o = acc[j];
        u32x2 w; w.x = pk2(o[0] * rstd * w4[0], o[1] * rstd * w4[1]); w.y = pk2(o[2] * rstd * w4[2], o[3] * rstd * w4[3]); if (P.rep == 0) *(u32x2*)(mix + (size_t)(t0 + t) * 1024 + 512 + n0) = w; }
    __syncthreads();
}

__device__ __forceinline__ void convact_phase(const Ctx& P, int layer, int slab) {
    unsigned char* ws = P.ws(); const bf16_t* up = (const bf16_t*)(ws + R_UP); bf16_t* act = (bf16_t*)(ws + R_ACT);
    const float* cw = P.in(I_FFN_CW) + (size_t)layer * 3 * UPW; const float* cb = P.in(I_FFN_CB) + (size_t)layer * UPW;
    const int R0 = slab * SLAB; constexpr int NCG = DFF / 8, RB = 16;
    for (int it = blockIdx.x * 512 + ltid(); it < (SLAB / RB) * NCG; it += gridDim.x * 512) {
        const int rb = it / NCG, cgi = it % NCG, c0 = cgi * 8, r0 = rb * RB;
        float wg[3][8], wv[3][8], bg[8], bv[8];
#pragma unroll
        for (int k = 0; k < 3; ++k)
#pragma unroll
            for (int hlf = 0; hlf < 2; ++hlf) { const f32x4 a = *(const f32x4*)(cw + k * UPW + c0 + 4 * hlf), b = *(const f32x4*)(cw + k * UPW + DFF + c0 + 4 * hlf);
#pragma unroll
                for (int j = 0; j < 4; ++j) { wg[k][4 * hlf + j] = a[j]; wv[k][4 * hlf + j] = b[j]; } }
#pragma unroll
        for (int hlf = 0; hlf < 2; ++hlf) { const f32x4 a = *(const f32x4*)(cb + c0 + 4 * hlf), b = *(const f32x4*)(cb + DFF + c0 + 4 * hlf);
#pragma unroll
            for (int j = 0; j < 4; ++j) { bg[4 * hlf + j] = a[j]; bv[4 * hlf + j] = b[j]; } }
        const u32x4 zz = {0u, 0u, 0u, 0u};
        u32x4 pg = zz, pv = zz;
        if (!tok_first(R0 + r0)) { pg = *(const u32x4*)(up + (size_t)(r0 - 1) * UPW + c0); pv = *(const u32x4*)(up + (size_t)(r0 - 1) * UPW + DFF + c0); }
        u32x4 cg_ = *(const u32x4*)(up + (size_t)r0 * UPW + c0), cv = *(const u32x4*)(up + (size_t)r0 * UPW + DFF + c0);
#pragma unroll 2
        for (int i = 0; i < RB; ++i) { const int r = r0 + i; u32x4 ng = zz, nv = zz;
            if (!tok_last(R0 + r)) { ng = *(const u32x4*)(up + (size_t)(r + 1) * UPW + c0); nv = *(const u32x4*)(up + (size_t)(r + 1) * UPW + DFF + c0); }
            float a0[8], a1[8], a2[8], b0[8], b1[8], b2[8], o[8];
            unpack8(pg, a0); unpack8(cg_, a1); unpack8(ng, a2); unpack8(pv, b0); unpack8(cv, b1); unpack8(nv, b2);
#pragma unroll
            for (int j = 0; j < 8; ++j) { const float gt = bg[j] + wg[0][j] * a0[j] + wg[1][j] * a1[j] + wg[2][j] * a2[j]; const float vl = bv[j] + wv[0][j] * b0[j] + wv[1][j] * b1[j] + wv[2][j] * b2[j]; o[j] = siluf_(gt) * vl; }
            *(u32x4*)(act + (size_t)r * DFF + c0) = pack8(o);
            pg = cg_; pv = cv; cg_ = ng; cv = nv; }
    }
}

__device__ __forceinline__ void final_phase(const Ctx& P) {
    const int lane = ltid() & 63, wave = ltid() >> 6; const float* part = (const float*)(P.ws() + W_PARTA); const float* fw = P.in(I_FINAL_NORM); const bf16_t* xb = (const bf16_t*)(P.ws() + R_XALT);
    for (int row = blockIdx.x * 8 + wave; row < M_TOK; row += gridDim.x * 8) { const float rs = row_rstd16(part, row);
#pragma unroll
        for (int j = 0; j < 4; ++j) { const u32x2 xw = ((const u32x2*)(xb + (size_t)row * 1024))[lane + 64 * j]; const f32x4 w = ((const f32x4*)fw)[lane + 64 * j];
            f32x4 v; v[0] = bflo(xw.x) * rs * w[0]; v[1] = bfhi(xw.x) * rs * w[1]; v[2] = bflo(xw.y) * rs * w[2]; v[3] = bfhi(xw.y) * rs * w[3];
            ((f32x4*)(P.out() + (size_t)row * 1024))[lane + 64 * j] = v; } }
}

#ifndef PHMASK
#define PHMASK 0xFFFFFFFFu
#endif
#define PHM(n) (((PHMASK) >> (n)) & 1u)
__device__ __forceinline__ void run_phase(const Ctx& P, int ph, unsigned char* shm) {
    unsigned char* ws = P.ws();
    if (ph == 0) { prep_weights(P, 0, shm); xinit_phase(P); return; }
    if (ph == N_PHASES - 1) { final_phase(P); return; }
    const int layer = (ph - 1) / PH_PER_LAYER, sub = (ph - 1) % PH_PER_LAYER;
    bf16_t* xbf = (bf16_t*)(ws + R_XBF); bf16_t* xalt = (bf16_t*)P.out();
    float* partA = (float*)(ws + W_PARTA); float* partB = (float*)(ws + W_PARTB);
    if (sub == 0) { EpiProj E; E.proj = (bf16_t*)(ws + R_PROJ); E.dt = (float*)(ws + W_DT); E.part = partA; run_gemm(shm, xalt, (const bf16_t*)(ws + woff(W_WIN, layer)), M_TOK, INP, 1024, E); }
    else if (sub == 1) {
        for (int it = blockIdx.x; it < 1536; it += gridDim.x) {
            if (it < 768) ssd_s1_item(P, layer, it, shm);
            else if (it < 1152) sgu_item(P, layer, it - 768, shm);
            else s5_item<false>(P, layer, it - 1152, shm);
        }
    }
    else if (sub == 2) {
        for (int it = blockIdx.x; it < 576; it += gridDim.x) ssd_scan_item(P, it);
        s5_carry(P, layer);
        pconv_phase(P, layer);
        if (layer + 1 < NLAYER) prep_weights(P, layer + 1, shm);
    }
    else if (sub == 3) {
        for (int it = blockIdx.x; it < 1152; it += gridDim.x) { if (it < 768) ssd_s3_item(P, layer, it, shm); else { s5_item<true>(P, layer, it - 768, shm); __syncthreads(); } }
    }
    else if (sub == 4) { for (int it = blockIdx.x; it < NCHUNK; it += gridDim.x) finalize_item(P, layer, it, shm); }
    else if (sub == 5) { EpiResid<false> E; E.xin = xalt; E.xout = xbf; E.part_out = partA; E.part_in = nullptr; E.e = nullptr; E.rep = P.rep; run_gemm(shm, (const bf16_t*)(ws + R_MIX), (const bf16_t*)(ws + woff(W_WOUT, layer)), M_TOK, 1024, 1024, E); }
    else if (sub == 6) { EpiUpConv E; E.act = (bf16_t*)(ws + R_UP); E.edge = (bf16_t*)(ws + W_EDGE); E.part = partA; E.cw = P.in(I_FFN_CW) + (size_t)layer * 3 * UPW; E.cb = P.in(I_FFN_CB) + (size_t)layer * UPW; E.xbuf = (unsigned*)(shm + 131072);
        run_gemm(shm, xbf, (const bf16_t*)(ws + woff(W_WUP, layer)), M_TOK, UPW, 1024, E); }
    else if (sub == 7) {
        ffn_fixup_phase(P, layer);
        EpiBf16S<false> E; E.O = (bf16_t*)(ws + R_E); E.ldc = 1024; E.part = nullptr; run_gemm(shm, (const bf16_t*)(ws + W_PBF), (const bf16_t*)(ws + woff(W_WP, layer)), M_TOK, 1024, 256, E); }
    else if (sub == 8) { EpiResid<false> E; E.xin = xbf; E.xout = xbf; E.part_out = partB; E.part_in = nullptr; E.e = nullptr; E.rep = P.rep; run_gemm(shm, (const bf16_t*)(ws + R_UP), (const bf16_t*)(ws + woff(W_WDOWN, layer)), M_TOK, 1024, DFF, E); }
    else { EpiResid<true> E; E.xin = xbf; E.xout = (layer == NLAYER - 1) ? (bf16_t*)(ws + R_XALT) : xalt; E.part_out = partA; E.part_in = partB; E.e = (const bf16_t*)(ws + R_E); E.rep = P.rep; run_gemm(shm, xbf, (const bf16_t*)(ws + woff(W_WG, layer)), M_TOK, 1024, 1024, E); }
}

#define XB_TMO      128
#define XB_XCNT(j)  (256  + 64 * (j))
#define XB_XSUB(j)  (1280 + 64 * (j))
#define XB_XGEN(j)  (2304 + 64 * (j))
#define XB_TOP      3328
#define XB_TOPGEN   3392
#define XCD_BAR_WORDS 3456
#define XB_SPIN_CAP (1u << 18)
#define LAS __attribute__((address_space(3)))

__device__ __forceinline__ unsigned xb_ld(unsigned* p)              { return __hip_atomic_load(p, __ATOMIC_RELAXED, __HIP_MEMORY_SCOPE_AGENT); }
__device__ __forceinline__ unsigned xb_add(unsigned* p, unsigned v) { return __hip_atomic_fetch_add(p, v, __ATOMIC_RELAXED, __HIP_MEMORY_SCOPE_AGENT); }
__device__ __forceinline__ unsigned xb_xcc_id() { return (unsigned)__builtin_amdgcn_s_getreg((3 << 11) | 20) & 0xFu; }
#define XB_SPIN(cond, bar) do { unsigned _sp = 0; while (cond) { __builtin_amdgcn_s_sleep(1); \
    if ((++_sp & 255u) == 0u) { if (xb_ld(&(bar)[XB_TMO])) break; if (_sp > XB_SPIN_CAP) { atomicAdd(&(bar)[XB_TMO], 1u); break; } } } } while (0)

struct XcdBarrier {
    unsigned* bar; unsigned x;
    volatile LAS unsigned* st;
};

__device__ __forceinline__ XcdBarrier xcd_barrier_post(unsigned* bar, volatile LAS unsigned* st) {
    XcdBarrier b; b.bar = bar; b.x = xb_xcc_id(); b.st = st;
    if (threadIdx.x == 0) (void)xb_add(&bar[XB_XCNT(b.x)], 1u);
    return b;
}
__device__ __forceinline__ void xcd_barrier_complete(unsigned* bar, unsigned x, unsigned& nloc, unsigned& nx) {
    const unsigned G = gridDim.x * gridDim.y * gridDim.z;
    unsigned sum, cnt, mine, sp = 0u;
    for (;;) {
        sum = 0u; cnt = 0u; mine = 0u;
#pragma unroll
        for (unsigned j = 0; j < 16; ++j) { const unsigned c = xb_ld(&bar[XB_XCNT(j)]); sum += c; cnt += (c > 0u) ? 1u : 0u; mine = (j == x) ? c : mine; }
        if (sum == G) break;
        __builtin_amdgcn_s_sleep(1);
        if ((++sp & 255u) == 0u) { if (xb_ld(&bar[XB_TMO])) break; if (sp > XB_SPIN_CAP) { atomicAdd(&bar[XB_TMO], 1u); break; } }
    }
    nloc = mine > 0u ? mine : 1u; nx = cnt > 0u ? cnt : 1u;
}

__device__ __forceinline__ void xcd_barrier(const XcdBarrier& b) {
    asm volatile("s_waitcnt vmcnt(0)" ::: "memory");
    __syncthreads();
    if (threadIdx.x == 0) {
        unsigned* bar = b.bar;
        __builtin_amdgcn_s_waitcnt(0);
        unsigned nloc = b.st[0], nx = b.st[1];
        if (nloc == 0u) { xcd_barrier_complete(bar, b.x, nloc, nx); b.st[0] = nloc; b.st[1] = nx; }
        const unsigned old = xb_add(&bar[XB_XSUB(b.x)], 1u);
        const unsigned gen = old / nloc;
        if (old + 1u == (gen + 1u) * nloc) {
            __builtin_amdgcn_fence(__ATOMIC_RELEASE, "agent");
            asm volatile("s_waitcnt vmcnt(0)" ::: "memory");
            const unsigned og = xb_add(&bar[XB_TOP], 1u);
            const unsigned tg = og / nx;
            if (og + 1u == (tg + 1u) * nx) xb_add(&bar[XB_TOPGEN], 1u);
            else XB_SPIN(xb_ld(&bar[XB_TOPGEN]) == tg, bar);
            __builtin_amdgcn_fence(__ATOMIC_ACQUIRE, "agent");
            xb_add(&bar[XB_XGEN(b.x)], 1u);
            asm volatile("s_waitcnt vmcnt(0)" ::: "memory");
        } else {
            XB_SPIN(xb_ld(&bar[XB_XGEN(b.x)]) == gen, bar);
            __builtin_amdgcn_fence(__ATOMIC_ACQUIRE, "agent");
            asm volatile("s_waitcnt vmcnt(0)" ::: "memory");
        }
    }
    __syncthreads();
}

__global__ void __launch_bounds__(512, 2) mega_fwd(Params P) {
    extern __shared__ __attribute__((aligned(16))) unsigned char shm[];
    cg::grid_group grid = cg::this_grid();
    if (P.ph_lo < 0) grid.sync();
    volatile LAS unsigned* st = (volatile LAS unsigned*)(shm + LDS_BYTES - 16);
    if (threadIdx.x == 0) { st[0] = 0u; st[1] = 0u; }
    __syncthreads();
    const XcdBarrier xb = xcd_barrier_post((unsigned*)(P.ws + W_BAR), st);
    for (int ph = P.ph_lo; ph < P.ph_hi; ++ph) {
        Ctx C; C.ka = (kaptr_t)__builtin_amdgcn_kernarg_segment_ptr(); asm volatile("" : "+s"(C.ka));
        C.rep = 0; run_phase(C, ph, shm);
#ifdef PROBE_MASK
        { const int sub_ = (ph - 1) % PH_PER_LAYER; if (ph > 0 && ph < N_PHASES - 1 && (((PROBE_MASK) >> sub_) & 1u)) { __syncthreads(); C.rep = 1; asm volatile("" : "+s"(C.rep)); run_phase(C, ph, shm); } }
#endif
        if (ph + 1 < P.ph_hi) xcd_barrier(xb);
    }
}

extern "C" void kernel_launch(void* const* d_in, const int* in_sizes, int n_in, void* d_out, int out_size, void* d_ws, size_t ws_size, hipStream_t stream) {
    static int grid = 0;
    if (grid == 0) {
        if (n_in != 38 || out_size != M_TOK * 1024 || ws_size < WS_TOTAL) { fprintf(stderr, "kernel_launch: unexpected shapes n_in %d out %d ws %zu (need %zu)\n", n_in, out_size, ws_size, (size_t)WS_TOTAL); grid = -1; return; }
        int dev = 0, cus = 0, per_cu = 0;
        (void)hipGetDevice(&dev); (void)hipDeviceGetAttribute(&cus, hipDeviceAttributeMultiprocessorCount, dev);
        if (hipFuncSetAttribute((const void*)mega_fwd, hipFuncAttributeMaxDynamicSharedMemorySize, LDS_BYTES) != hipSuccess) { fprintf(stderr, "kernel_launch: hipFuncSetAttribute failed\n"); grid = -1; return; }
        if (hipOccupancyMaxActiveBlocksPerMultiprocessor(&per_cu, (const void*)mega_fwd, 512, LDS_BYTES) != hipSuccess || per_cu < 1) { fprintf(stderr, "kernel_launch: occupancy query says %d\n", per_cu); per_cu = 1; }
        (void)hipGetLastError();
        grid = cus * per_cu;
    }
    if (grid < 0) return;
    Params p{};
    for (int i = 0; i < 38; ++i) p.in[i] = (const float*)d_in[i];
    p.out = (float*)d_out; p.ws = (unsigned char*)d_ws;
#ifdef DBG_FILL
    (void)hipMemsetAsync(d_ws, 0, WS_TOTAL, stream);
#endif
    (void)hipMemsetAsync((unsigned char*)d_ws + W_BAR, 0, 16384, stream);
#if SINGLE_LAUNCH
    p.ph_lo = 0; p.ph_hi = N_PHASES;
    void* args[] = {&p};
    hipError_t e = hipLaunchCooperativeKernel((const void*)mega_fwd, dim3(grid), dim3(512), args, LDS_BYTES, stream);
    if (e != hipSuccess) fprintf(stderr, "cooperative launch failed: %s (grid %d)\n", hipGetErrorString(e), grid);
#else
    for (int ph = 0; ph < N_PHASES; ++ph) { p.ph_lo = ph; p.ph_hi = ph + 1; hipLaunchKernelGGL(mega_fwd, dim3(grid), dim3(512), LDS_BYTES, stream, p); }
#endif
}
```

```cpp
#include <hip/hip_runtime.h>
#include <hip/hip_cooperative_groups.h>
#include <cstdio>
#include <cstdint>
namespace cg = cooperative_groups;
#ifndef SINGLE_LAUNCH
#define SINGLE_LAUNCH 1
#endif
namespace pg8 {
#define PG8_LAS __attribute__((address_space(3)))
typedef unsigned short bf16_t;
typedef short bf16x8 __attribute__((ext_vector_type(8)));
typedef float f32x4 __attribute__((ext_vector_type(4)));
typedef unsigned u32x4 __attribute__((ext_vector_type(4)));
constexpr int BM = 256, BK = 64, HALF = 128, HTB = HALF * BK * 2  , STAGE_BYTES = 8 * HTB, NXCD = 8, WGM = 8;

__host__ __device__ __forceinline__ int lds_byte(int r, int c) { const int st = (r >> 4) * 2 + (c >> 5), rr = r & 15, cc = c & 31, ob = rr * 64 + cc * 2; return st * 1024 + (ob ^ (((ob >> 9) & 1) << 5)); }
__host__ __device__ __forceinline__ void stage_rc(int b, int& R, int& C) { const int st = b / 1024, sb = b % 1024, swz = sb ^ (((sb >> 9) & 1) << 5); R = (st >> 1) * 16 + swz / 64; C = (st & 1) * 32 + (swz % 64) / 2; }
__host__ __device__ __forceinline__ int perm32(int rho) { const int n = rho >> 4, i = rho & 15; return 8 * (i >> 2) + 4 * n + (i & 3); }

struct Unit { int pm, pn; };
struct Gemm { const bf16_t* A; const bf16_t* Bt; int M, N, K; };

struct StaticOrder {
    int nM, nN, nwg, G, c;
    __host__ __device__ void init(int M, int N, int G_, int c_) { nM = M / BM; nN = N / BM; nwg = nM * nN; G = G_; c = c_; }
    __host__ __device__ bool next(int i, Unit& u) const {
        const long L = (long)i * G + c; if (L >= nwg) return false;
        int wgid = (int)L; { const int q = nwg / NXCD, r = nwg % NXCD, xcd = wgid % NXCD, off = wgid / NXCD; wgid = (xcd < r ? xcd * (q + 1) : r * (q + 1) + (xcd - r) * q) + off; }
        const int nig = WGM * nN, gid = wgid / nig, fm = gid * WGM, gsz = (nM - fm) < WGM ? (nM - fm) : WGM;
        u.pm = fm + ((wgid % nig) % gsz); u.pn = (wgid % nig) / gsz; return true;
    }
    __device__ __forceinline__ void a_ready(const Unit&) const {}
    __device__ __forceinline__ void done(const Unit&) const {}
};

template <class Epi, class Sched, bool ALIGN_EPI = false, bool SP2 = false>
__device__ __forceinline__ void gemm_phase(PG8_LAS unsigned char* lds, const Gemm g, const Sched& S, const Epi& E) {
    int tid_ = threadIdx.x; asm volatile("" : "+v"(tid_)); const int tid = tid_, wid = __builtin_amdgcn_readfirstlane(tid >> 6), lane = tid & 63, wr = wid >> 2, wc = wid & 3, fr = lane & 15, fq = lane >> 4;
    const int K = g.K, nt = K / BK;
    unsigned voffA[2], voffB[2];
#pragma unroll
    for (int i = 0; i < 2; ++i) { int R, C; stage_rc(tid * 16 + i * 8192, R, C); const int Rb = Epi::PERM ? ((R & ~31) + perm32(R & 31)) : R;
        voffA[i] = (unsigned)(R * K + C) * 2u; voffB[i] = (unsigned)(Rb * K + C) * 2u; }
    const size_t kstep = (size_t)(BK * 2);
    const size_t hstep = (size_t)HALF * K * 2;
    const size_t tstep = 2 * hstep;
    const unsigned ldsw = (unsigned)wid * 1024u;
    const int aoff = lds_byte(wr * 64 + fr, fq * 8), boff = lds_byte(wc * 32 + fr, fq * 8);
#define PG8_SA(b, h) (((b) * 2 + (h)) * HTB)
#define PG8_SB(b, h) ((4 + (b) * 2 + (h)) * HTB)
#define PG8_STAGE(bufoff, gbase, voff) do { _Pragma("unroll") for (int _i = 0; _i < 2; ++_i) \
        __builtin_amdgcn_global_load_lds((const unsigned*)((const char*)(gbase) + (voff)[_i]), (PG8_LAS unsigned*)(lds + (bufoff) + ldsw + _i * 8192), 16, 0, 0); } while (0)
#define PG8_LDA(dst, b, h) do { _Pragma("unroll") for (int m = 0; m < 4; ++m) _Pragma("unroll") for (int k = 0; k < 2; ++k) dst[m][k] = *(const PG8_LAS bf16x8*)(lds + PG8_SA(b, h) + aoff + m * 2048 + k * 1024); } while (0)
#define PG8_LDB(dst, b, h) do { _Pragma("unroll") for (int n = 0; n < 2; ++n) _Pragma("unroll") for (int k = 0; k < 2; ++k) dst[n][k] = *(const PG8_LAS bf16x8*)(lds + PG8_SB(b, h) + boff + n * 2048 + k * 1024); } while (0)
#define PG8_MMA(ai, bj, At, Bt) do { __builtin_amdgcn_s_setprio(1); _Pragma("unroll") for (int m = 0; m < 4; ++m) _Pragma("unroll") for (int n = 0; n < 2; ++n) _Pragma("unroll") for (int k = 0; k < 2; ++k) \
        acc[ai][bj][m][n] = __builtin_amdgcn_mfma_f32_16x16x32_bf16(Bt[n][k], At[m][k], acc[ai][bj][m][n], 0, 0, 0); __builtin_amdgcn_s_setprio(0); } while (0)
#define PG8_WAIT_V(n) asm volatile("s_waitcnt vmcnt(" #n ")" ::: "memory")
#define PG8_WAIT_L(n) asm volatile("s_waitcnt lgkmcnt(" #n ")" ::: "memory")
#define PG8_BAR __builtin_amdgcn_s_barrier()
#define PG8_SCHED __builtin_amdgcn_sched_barrier(0)
    Unit cur, nxt; int ui = 0;
    if (!S.next(0, cur)) return;
    f32x4 acc[2][2][4][2];
#pragma unroll
    for (int a = 0; a < 2; ++a)
#pragma unroll
        for (int b = 0; b < 2; ++b)
#pragma unroll
            for (int m = 0; m < 4; ++m)
#pragma unroll
                for (int n = 0; n < 2; ++n) acc[a][b][m][n] = (f32x4){0.f, 0.f, 0.f, 0.f};
    bf16x8 At[4][2], B0[2][2], B1[2][2];
    const char* cA = (const char*)g.A + (size_t)cur.pm * tstep; const char* cB = (const char*)g.Bt + (size_t)cur.pn * tstep;
    S.a_ready(cur);
    if constexpr (SP2) {
        PG8_STAGE(PG8_SB(0, 0), cB, voffB); PG8_STAGE(PG8_SB(0, 1), cB + hstep, voffB); PG8_STAGE(PG8_SA(0, 0), cA, voffA); PG8_STAGE(PG8_SA(0, 1), cA + hstep, voffA);
        if (wr == 1) PG8_BAR;
        PG8_WAIT_V(2); PG8_BAR;
        PG8_STAGE(PG8_SB(1, 0), cB + kstep, voffB); PG8_STAGE(PG8_SA(1, 0), cA + kstep, voffA); PG8_STAGE(PG8_SB(1, 1), cB + hstep + kstep, voffB);
        PG8_WAIT_V(6); PG8_BAR;
    } else {
        PG8_STAGE(PG8_SB(0, 0), cB, voffB); PG8_STAGE(PG8_SA(0, 0), cA, voffA); PG8_STAGE(PG8_SB(0, 1), cB + hstep, voffB); PG8_STAGE(PG8_SA(0, 1), cA + hstep, voffA);
        if (wr == 1) PG8_BAR;
        PG8_WAIT_V(4); PG8_BAR;
        PG8_STAGE(PG8_SB(1, 0), cB + kstep, voffB); PG8_STAGE(PG8_SA(1, 0), cA + kstep, voffA); PG8_STAGE(PG8_SB(1, 1), cB + hstep + kstep, voffB);
        PG8_WAIT_V(6); PG8_BAR;
    }
    for (;;) {
        const bool has_next = S.next(ui + 1, nxt);
        const char* nA = has_next ? (const char*)g.A + (size_t)nxt.pm * tstep : cA; const char* nB = has_next ? (const char*)g.Bt + (size_t)nxt.pn * tstep : cB;
        for (int t = 0; t < nt; t += 2) {
            const bool last = (t == nt - 2);
            const char* a1 = cA + (size_t)(t + 1) * kstep;
            const char* a2 = last ? nA : cA + (size_t)(t + 2) * kstep; const char* b2 = last ? nB : cB + (size_t)(t + 2) * kstep;
            const char* a3 = a2 + kstep; const char* b3 = b2 + kstep;
            if (last && has_next) S.a_ready(nxt);
            if constexpr (SP2) {
            PG8_LDB(B0, 0, 0); PG8_LDB(B1, 0, 1); PG8_SCHED; PG8_LDA(At, 0, 0); PG8_STAGE(PG8_SA(1, 1), a1 + hstep, voffA);
            PG8_WAIT_V(8); PG8_WAIT_L(0); PG8_BAR; PG8_MMA(0, 0, At, B0); PG8_MMA(0, 1, At, B1); PG8_BAR; PG8_SCHED;
            PG8_LDA(At, 0, 1); PG8_STAGE(PG8_SB(0, 0), b2, voffB); PG8_STAGE(PG8_SB(0, 1), b2 + hstep, voffB); PG8_STAGE(PG8_SA(0, 0), a2, voffA);
            PG8_WAIT_V(8); PG8_WAIT_L(0); PG8_BAR; PG8_MMA(1, 0, At, B0); PG8_MMA(1, 1, At, B1); PG8_BAR; PG8_SCHED;
            PG8_LDB(B0, 1, 0); PG8_LDB(B1, 1, 1); PG8_SCHED; PG8_LDA(At, 1, 0); PG8_STAGE(PG8_SA(0, 1), a2 + hstep, voffA);
            PG8_WAIT_V(8); PG8_WAIT_L(0); PG8_BAR; PG8_MMA(0, 0, At, B0); PG8_MMA(0, 1, At, B1); PG8_BAR; PG8_SCHED;
            PG8_LDA(At, 1, 1); PG8_STAGE(PG8_SB(1, 0), b3, voffB); PG8_STAGE(PG8_SB(1, 1), b3 + hstep, voffB); PG8_STAGE(PG8_SA(1, 0), a3, voffA);
            PG8_WAIT_V(8); PG8_WAIT_L(0); PG8_BAR; PG8_MMA(1, 0, At, B0); PG8_MMA(1, 1, At, B1); PG8_BAR; PG8_SCHED;
            } else {
            PG8_LDB(B0, 0, 0); PG8_SCHED; PG8_LDA(At, 0, 0); PG8_STAGE(PG8_SA(1, 1), a1 + hstep, voffA);
            PG8_WAIT_L(8); PG8_BAR; PG8_WAIT_L(0); PG8_MMA(0, 0, At, B0); PG8_BAR; PG8_SCHED;
            PG8_LDB(B1, 0, 1); PG8_STAGE(PG8_SB(0, 0), b2, voffB);
            PG8_BAR; PG8_WAIT_L(0); PG8_MMA(0, 1, At, B1); PG8_BAR;
            PG8_LDA(At, 0, 1); PG8_STAGE(PG8_SA(0, 0), a2, voffA);
            PG8_BAR; PG8_WAIT_L(0); PG8_MMA(1, 0, At, B0); PG8_BAR; PG8_SCHED;
            PG8_STAGE(PG8_SB(0, 1), b2 + hstep, voffB);
            PG8_WAIT_V(6); PG8_BAR; PG8_MMA(1, 1, At, B1); PG8_BAR;
            PG8_LDB(B0, 1, 0); PG8_SCHED; PG8_LDA(At, 1, 0); PG8_STAGE(PG8_SA(0, 1), a2 + hstep, voffA);
            PG8_WAIT_L(8); PG8_BAR; PG8_WAIT_L(0); PG8_MMA(0, 0, At, B0); PG8_BAR; PG8_SCHED;
            PG8_LDB(B1, 1, 1); PG8_STAGE(PG8_SB(1, 0), b3, voffB);
            PG8_BAR; PG8_WAIT_L(0); PG8_MMA(0, 1, At, B1); PG8_BAR;
            PG8_LDA(At, 1, 1); PG8_STAGE(PG8_SA(1, 0), a3, voffA);
            PG8_BAR; PG8_WAIT_L(0); PG8_MMA(1, 0, At, B0); PG8_BAR; PG8_SCHED;
            PG8_STAGE(PG8_SB(1, 1), b3 + hstep, voffB);
            PG8_WAIT_V(6); PG8_BAR; PG8_MMA(1, 1, At, B1); PG8_BAR;
            }
        }
        if constexpr (ALIGN_EPI) { if (wr == 0) PG8_BAR; }
        if constexpr (!Epi::AFTER_DRAIN) { E(acc, cur, wr, wc, fr, fq); S.done(cur); }
        if (!has_next) break;
#pragma unroll
        for (int a = 0; a < 2; ++a)
#pragma unroll
            for (int b = 0; b < 2; ++b)
#pragma unroll
                for (int m = 0; m < 4; ++m)
#pragma unroll
                    for (int n = 0; n < 2; ++n) acc[a][b][m][n] = (f32x4){0.f, 0.f, 0.f, 0.f};
        cur = nxt; cA = nA; cB = nB; ++ui;
        if constexpr (ALIGN_EPI) { if (wr == 1) PG8_BAR; }
    }
    PG8_WAIT_V(0);
    if constexpr (!ALIGN_EPI) { if (wr == 0) PG8_BAR; }
    PG8_BAR;
    if constexpr (Epi::AFTER_DRAIN) { E.fused(acc, cur, wr, wc, fr, fq, lds, wid, lane); S.done(cur); }
#undef PG8_SA
#undef PG8_SB
#undef PG8_STAGE
#undef PG8_LDA
#undef PG8_LDB
#undef PG8_MMA
#undef PG8_WAIT_V
#undef PG8_WAIT_L
#undef PG8_BAR
#undef PG8_SCHED
}
}
using pg8::bf16_t; using pg8::bf16x8; using pg8::f32x4; using pg8::u32x4; using pg8::Unit;
typedef short bf16x4 __attribute__((ext_vector_type(4)));
typedef unsigned u32x2 __attribute__((ext_vector_type(2)));
typedef float f32x2v __attribute__((ext_vector_type(2)));

constexpr int M_TOK = 49152, MP = 32768, DM = 1024, INW = 2320, INP = 2560, DFF = 2816, UPW = 5632, PLE = 256;
constexpr int O_XBC = 512, O_DT = 1536, O_S5 = 1552, O_SGU = 1808;
constexpr int NCHUNK = 384, SLAB = 16384, NSLAB = 3, NLAYER = 4;
constexpr int LDS_BYTES = 147456;
constexpr int PH_PER_LAYER = 10, N_PHASES = NLAYER * PH_PER_LAYER + 2;

constexpr size_t SZ_XBF = (size_t)M_TOK * 1024 * 2;
constexpr size_t SZ_PROJ = (size_t)M_TOK * INW * 2;
constexpr size_t SZ_STATES = (size_t)NCHUNK * 2 * 8 * 8192 * 2;
constexpr size_t SZ_S5Y = (size_t)2 * M_TOK * 256 * 2;
constexpr size_t SZ_UP = (size_t)SLAB * UPW * 2;
constexpr size_t SZ_ACT = (size_t)SLAB * DFF * 2;
constexpr size_t R_PROJ = 0, R_STATES = SZ_PROJ, R_MIX = R_STATES + SZ_STATES, R_S5Y = R_MIX + SZ_XBF, R_END = R_S5Y + SZ_S5Y;
constexpr size_t R_XBF = 0, R_UP = SZ_XBF, R_ACT = R_UP + SZ_UP, R_XALT = R_ACT + SZ_ACT, R_E = R_XALT;
static_assert(R_XALT + SZ_XBF <= R_END, "xalt must fit");
static_assert(R_XALT >= SZ_PROJ, "xalt must not overlap proj");
constexpr size_t W_WIN = R_END;
constexpr size_t W_WOUT = W_WIN + (size_t)INP * 1024 * 2;
constexpr size_t W_WUP = W_WOUT + (size_t)1024 * 1024 * 2;
constexpr size_t W_WDOWN = W_WUP + (size_t)UPW * 1024 * 2;
constexpr size_t W_WP = W_WDOWN + (size_t)1024 * DFF * 2;
constexpr size_t W_WG = W_WP + (size_t)1024 * 256 * 2;
constexpr size_t W_GLU = W_WG + (size_t)1024 * 1024 * 2;
constexpr size_t W_SGU = W_GLU + (size_t)256 * 256 * 2;
constexpr size_t W_PBF = W_SGU + (size_t)4 * 128 * 128 * 2;
constexpr size_t W_DT = W_PBF + (size_t)M_TOK * 256 * 2;
constexpr size_t W_PARTA = W_DT + (size_t)M_TOK * 16 * 4;
constexpr size_t W_PARTB = W_PARTA + (size_t)M_TOK * 16 * 4;
constexpr size_t W_SSQ = W_PARTB + (size_t)M_TOK * 16 * 4;
constexpr size_t W_DECAY = W_SSQ + (size_t)M_TOK * 2 * 4;
constexpr size_t W_HLOC = W_DECAY + (size_t)NCHUNK * 16 * 4;
constexpr size_t W_HIN = W_HLOC + (size_t)NCHUNK * 2 * 16 * 64 * 8;
constexpr size_t W_AB = W_HIN + (size_t)NCHUNK * 2 * 16 * 64 * 8;
constexpr size_t W_ABL = W_AB + (size_t)2 * 16 * 64 * 8;
constexpr size_t W_BOP = W_ABL + (size_t)2 * 16 * 64 * 8;
constexpr size_t W_COP = W_BOP + (size_t)2 * 16 * 128 * 16 * 2;
constexpr size_t W_EDGE = W_COP + (size_t)16 * 16 * 128 * 2;
constexpr size_t W_BAR = W_EDGE + (size_t)(M_TOK / 256) * 4 * 2 * DFF * 2;
constexpr size_t W2_BASE = W_BAR + 16384;
constexpr size_t WS_TOTAL = W2_BASE + (W_PBF - W_WIN) + (W_EDGE - W_AB);
__host__ __device__ __forceinline__ size_t woff(size_t off, int layer) { return !(layer & 1) ? off : (off < W_PBF ? W2_BASE + (off - W_WIN) : W2_BASE + (W_PBF - W_WIN) + (off - W_AB)); }

struct Params {
    const float* in[38];
    float* out; unsigned char* ws;
    int ph_lo, ph_hi;
};
typedef const __attribute__((address_space(4))) unsigned char* kaptr_t;
struct Ctx {
    kaptr_t ka; int rep;
    __device__ __forceinline__ const float* in(int i) const { return *(const float* const __attribute__((address_space(4)))*)(ka + 8 * i); }
    __device__ __forceinline__ float* out() const { return *(float* const __attribute__((address_space(4)))*)(ka + 8 * 38); }
    __device__ __forceinline__ unsigned char* ws() const { return *(unsigned char* const __attribute__((address_space(4)))*)(ka + 8 * 39); }
};
enum { I_XP = 0, I_XS, I_PP, I_PS, I_NORM_MIX, I_W_IN, I_SSD_CW, I_SSD_CB, I_SSD_DTB, I_SSD_ALOG, I_SSD_D, I_SSD_NORM, I_S5_LRE, I_S5_LIM, I_S5_LSTEP,
       I_S5_BRE, I_S5_BIM, I_S5_CRE, I_S5_CIM, I_S5_D, I_S5_GLUW, I_S5_GLUB, I_S5_ONORM, I_SGU_NW, I_SGU_NB, I_SGU_W, I_SGU_B, I_SGU_ONORM, I_W_OUT, I_NORM_FFN,
       I_FFN_UP, I_FFN_CW, I_FFN_CB, I_FFN_DOWN, I_PLE_PROJ, I_PLE_NORM, I_PLE_GATE, I_FINAL_NORM };

__device__ __forceinline__ int ltid() { int t = threadIdx.x; asm volatile("" : "+v"(t)); return t; }
__device__ __forceinline__ float bflo(unsigned w) { return __uint_as_float(w << 16); }
__device__ __forceinline__ float bfhi(unsigned w) { return __uint_as_float(w & 0xffff0000u); }
__device__ __forceinline__ float bf2f(bf16_t b) { return __uint_as_float(((unsigned)b) << 16); }
typedef __bf16 nbf16x2 __attribute__((ext_vector_type(2)));
__device__ __forceinline__ unsigned pk2(float lo, float hi) { f32x2v v; v.x = lo; v.y = hi; const nbf16x2 b = __builtin_convertvector(v, nbf16x2); return __builtin_bit_cast(unsigned, b); }
__device__ __forceinline__ bf16_t f2bf(float f) { return (bf16_t)(pk2(f, 0.f) & 0xffffu); }
__device__ __forceinline__ void unpack8(const u32x4 r, float (&v)[8]) { v[0] = bflo(r.x); v[1] = bfhi(r.x); v[2] = bflo(r.y); v[3] = bfhi(r.y); v[4] = bflo(r.z); v[5] = bfhi(r.z); v[6] = bflo(r.w); v[7] = bfhi(r.w); }
__device__ __forceinline__ u32x4 pack8(const float (&v)[8]) { u32x4 o; o.x = pk2(v[0], v[1]); o.y = pk2(v[2], v[3]); o.z = pk2(v[4], v[5]); o.w = pk2(v[6], v[7]); return o; }
__device__ __forceinline__ float sigmoidf_(float x) { return __builtin_amdgcn_rcpf(1.0f + __builtin_amdgcn_exp2f(x * -1.4426950408889634f)); }
__device__ __forceinline__ float siluf_(float x) { return x * sigmoidf_(x); }
__device__ __forceinline__ float geluf_(float x) { const float u = 0.7978845608f * (x + 0.044715f * x * x * x); return x * sigmoidf_(2.0f * u); }
__device__ __forceinline__ float softplusf_(float x) { return x > 20.f ? x : __logf(1.0f + __expf(x)); }
__device__ __forceinline__ bool tok_first(int t) { return t < MP ? ((t & 2047) == 0) : (((t - MP) & 8191) == 0); }
__device__ __forceinline__ bool tok_last(int t) { return t < MP ? ((t & 2047) == 2047) : (((t - MP) & 8191) == 8191); }
__device__ __forceinline__ float wave_incl_scan(float v, int lane) {
#pragma unroll
    for (int o = 1; o < 64; o <<= 1) { const float t = __shfl_up(v, o); if (lane >= o) v += t; }
    return v;
}
__device__ __forceinline__ float row_rstd16(const float* part, int row) {
    const f32x4* p = (const f32x4*)(part + (size_t)row * 16);
    const f32x4 a = p[0], b = p[1], c = p[2], d = p[3];
    const float s = (((a[0] + a[1]) + (a[2] + a[3])) + ((b[0] + b[1]) + (b[2] + b[3]))) + (((c[0] + c[1]) + (c[2] + c[3])) + ((d[0] + d[1]) + (d[2] + d[3])));
    return rsqrtf(s * (1.0f / 1024.0f) + 1e-6f);
}
struct RowRs { float s0, s1; };
__device__ __forceinline__ RowRs rowrs_load(const float* part, int rowbase  , int lane) {
    RowRs r; const int rr = rowbase + (lane >> 4) * 16 + (lane & 15); r.s0 = row_rstd16(part, rr); r.s1 = row_rstd16(part, rr + 128); return r;
}
__device__ __forceinline__ float rowrs_get(const RowRs& r, int ai, int m, int fr) { return __shfl(ai ? r.s1 : r.s0, m * 16 + fr); }
__device__ __forceinline__ int prow(int j, int i) { return 32 * (j >> 1) + 8 * (i >> 2) + 4 * (j & 1) + (i & 3); }
typedef short s16x4 __attribute__((ext_vector_type(4)));
__device__ __forceinline__ s16x4 lds_tr4(const bf16_t* p) { return __builtin_amdgcn_ds_read_tr16_b64_v4i16((__attribute__((address_space(3))) s16x4*)p); }
#define MFMA32(a, b, c) __builtin_amdgcn_mfma_f32_16x16x32_bf16((a), (b), (c), 0, 0, 0)
#define MFMA16(a, b, c) __builtin_amdgcn_mfma_f32_16x16x16bf16_1k((a), (b), (c), 0, 0, 0)
#define WAVE_LDS_FENCE() do { asm volatile("s_waitcnt lgkmcnt(0)" ::: "memory"); __builtin_amdgcn_wave_barrier(); } while (0)

#ifndef GEMM_ALIGN_EPI
#define GEMM_ALIGN_EPI true
#endif
#ifndef GEMM_SP2
#define GEMM_SP2 true
#endif
struct EpiProj {
    static constexpr bool PERM = true, AFTER_DRAIN = false;
    bf16_t* proj; float* dt; const float* part;
    __device__ __forceinline__ void operator()(const f32x4 (&acc)[2][2][4][2], const Unit& u, int wr, int wc, int fr, int fq) const {
        const int row0 = u.pm * 256 + wr * 64 + fr, colb = u.pn * 256 + wc * 32 + 8 * fq;
        const RowRs rr = rowrs_load(part, u.pm * 256 + wr * 64, fq * 16 + fr);
#pragma unroll
        for (int ai = 0; ai < 2; ++ai)
#pragma unroll
            for (int m = 0; m < 4; ++m) {
                const int row = row0 + ai * 128 + m * 16; const float rs = rowrs_get(rr, ai, m, fr);
#pragma unroll
                for (int bj = 0; bj < 2; ++bj) {
                    const int col = colb + bj * 128; const f32x4 v0 = acc[ai][bj][m][0] * rs, v1 = acc[ai][bj][m][1] * rs;
                    if (col < INW) { u32x4 w; w.x = pk2(v0[0], v0[1]); w.y = pk2(v0[2], v0[3]); w.z = pk2(v1[0], v1[1]); w.w = pk2(v1[2], v1[3]); *(u32x4*)(proj + (size_t)row * INW + col) = w; }
                    if (col >= O_DT && col < O_DT + 16) { float* d = dt + (size_t)row * 16 + (col - O_DT); *(f32x4*)d = v0; *(f32x4*)(d + 4) = v1; }
                }
            }
    }
};
template <bool SCALE> struct EpiBf16S {
    static constexpr bool PERM = true, AFTER_DRAIN = false;
    bf16_t* O; int ldc; const float* part;
    __device__ __forceinline__ void operator()(const f32x4 (&acc)[2][2][4][2], const Unit& u, int wr, int wc, int fr, int fq) const {
        const int row0 = u.pm * 256 + wr * 64 + fr, colb = u.pn * 256 + wc * 32 + 8 * fq;
        RowRs rr; rr.s0 = 1.f; rr.s1 = 1.f; if (SCALE) rr = rowrs_load(part, u.pm * 256 + wr * 64, fq * 16 + fr);
#pragma unroll
        for (int ai = 0; ai < 2; ++ai)
#pragma unroll
            for (int m = 0; m < 4; ++m) {
                const int row = row0 + ai * 128 + m * 16; float rs = 1.0f; if (SCALE) rs = rowrs_get(rr, ai, m, fr);
#pragma unroll
                for (int bj = 0; bj < 2; ++bj) {
                    const int col = colb + bj * 128; const f32x4 v0 = acc[ai][bj][m][0] * rs, v1 = acc[ai][bj][m][1] * rs;
                    u32x4 w; w.x = pk2(v0[0], v0[1]); w.y = pk2(v0[2], v0[3]); w.z = pk2(v1[0], v1[1]); w.w = pk2(v1[2], v1[3]); *(u32x4*)(O + (size_t)row * ldc + col) = w;
                }
            }
    }
};
template <bool GATE> struct EpiResid {
    static constexpr bool PERM = true, AFTER_DRAIN = false;
    const bf16_t* xin; bf16_t* xout; float* part_out; const float* part_in; const bf16_t* e; int rep;
    __device__ __forceinline__ void operator()(const f32x4 (&acc)[2][2][4][2], const Unit& u, int wr, int wc, int fr, int fq) const {
        const int row0 = u.pm * 256 + wr * 64 + fr, colb = u.pn * 256 + wc * 32 + 8 * fq;
        RowRs rr; rr.s0 = 1.f; rr.s1 = 1.f; if (GATE) rr = rowrs_load(part_in, u.pm * 256 + wr * 64, fq * 16 + fr);
#pragma unroll
        for (int ai = 0; ai < 2; ++ai)
#pragma unroll
            for (int m = 0; m < 4; ++m) {
                const int row = row0 + ai * 128 + m * 16; float rs = 1.0f; if (GATE) rs = rowrs_get(rr, ai, m, fr);
                float ss = 0.f;
#pragma unroll
                for (int bj = 0; bj < 2; ++bj) {
                    const size_t o = (size_t)row * 1024 + colb + bj * 128;
                    float v[8]; unpack8(*(const u32x4*)(xin + o), v);
                    const f32x4 a0 = acc[ai][bj][m][0], a1 = acc[ai][bj][m][1];
                    if (GATE) { float ev[8]; unpack8(*(const u32x4*)(e + o), ev);
#pragma unroll
                        for (int j = 0; j < 4; ++j) { v[j] += sigmoidf_(a0[j] * rs) * ev[j]; v[4 + j] += sigmoidf_(a1[j] * rs) * ev[4 + j]; } }
                    else {
#pragma unroll
                        for (int j = 0; j < 4; ++j) { v[j] += a0[j]; v[4 + j] += a1[j]; } }
                    if (rep == 0) *(u32x4*)(xout + o) = pack8(v);
#pragma unroll
                    for (int j = 0; j < 8; ++j) ss += v[j] * v[j];
                }
                ss += __shfl_xor(ss, 16); ss += __shfl_xor(ss, 32);
                if (fq == 0 && rep == 0) part_out[(size_t)row * 16 + u.pn * 4 + wc] = ss;
                if (m == 1 || m == 3) asm volatile("" ::: "memory");
            }
    }
};
struct EpiUpConv {
    static constexpr bool PERM = true, AFTER_DRAIN = false;
    bf16_t* act; bf16_t* edge; const float* part; const float* cw; const float* cb; unsigned* xbuf;
    __device__ __forceinline__ void operator()(const f32x4 (&acc)[2][2][4][2], const Unit& u, int wr, int wc, int fr, int fq) const {
        const int lane = fq * 16 + fr; const int ch0 = u.pn * 128 + wc * 32 + 8 * fq;
        const RowRs rr = rowrs_load(part, u.pm * 256 + wr * 64, lane);
        unsigned G[2][4][4], V[2][4][4];
#pragma unroll
        for (int ai = 0; ai < 2; ++ai)
#pragma unroll
            for (int m = 0; m < 4; ++m) { const float rs = rowrs_get(rr, ai, m, fr);
                const f32x4 g0 = acc[ai][0][m][0] * rs, g1 = acc[ai][0][m][1] * rs, v0 = acc[ai][1][m][0] * rs, v1 = acc[ai][1][m][1] * rs;
                G[ai][m][0] = pk2(g0[0], g0[1]); G[ai][m][1] = pk2(g0[2], g0[3]); G[ai][m][2] = pk2(g1[0], g1[1]); G[ai][m][3] = pk2(g1[2], g1[3]);
                V[ai][m][0] = pk2(v0[0], v0[1]); V[ai][m][1] = pk2(v0[2], v0[3]); V[ai][m][2] = pk2(v1[0], v1[1]); V[ai][m][3] = pk2(v1[2], v1[3]); }
#pragma unroll
        for (int ai = 0; ai < 2; ++ai) { const int g4 = 2 * ai + wr;
            if (fr == 0) { unsigned* d = xbuf + ((((g4 * 2 + 0) * 4 + wc) * 4 + fq) * 8); *(u32x4*)d = (u32x4){G[ai][0][0], G[ai][0][1], G[ai][0][2], G[ai][0][3]}; *(u32x4*)(d + 4) = (u32x4){V[ai][0][0], V[ai][0][1], V[ai][0][2], V[ai][0][3]}; }
            if (fr == 15) { unsigned* d = xbuf + ((((g4 * 2 + 1) * 4 + wc) * 4 + fq) * 8); *(u32x4*)d = (u32x4){G[ai][3][0], G[ai][3][1], G[ai][3][2], G[ai][3][3]}; *(u32x4*)(d + 4) = (u32x4){V[ai][3][0], V[ai][3][1], V[ai][3][2], V[ai][3][3]}; } }
        if (wr == 0 && fr < 2) { bf16_t* d = edge + ((size_t)(u.pm * 4 + fr) * 2) * DFF + ch0; *(u32x4*)d = (u32x4){G[0][0][0], G[0][0][1], G[0][0][2], G[0][0][3]}; *(u32x4*)(d + DFF) = (u32x4){V[0][0][0], V[0][0][1], V[0][0][2], V[0][0][3]}; }
        if (wr == 1 && fr >= 14) { bf16_t* d = edge + ((size_t)(u.pm * 4 + 2 + (fr - 14)) * 2) * DFF + ch0; *(u32x4*)d = (u32x4){G[1][3][0], G[1][3][1], G[1][3][2], G[1][3][3]}; *(u32x4*)(d + DFF) = (u32x4){V[1][3][0], V[1][3][1], V[1][3][2], V[1][3][3]}; }
        asm volatile("s_waitcnt lgkmcnt(0)" ::: "memory"); __builtin_amdgcn_s_barrier(); asm volatile("" ::: "memory");
        if (!GEMM_ALIGN_EPI) { __builtin_amdgcn_s_barrier(); asm volatile("" ::: "memory"); }
        float wg[3][8], wv[3][8], bg[8], bv[8];
#pragma unroll
        for (int k = 0; k < 3; ++k)
#pragma unroll
            for (int hlf = 0; hlf < 2; ++hlf) { const f32x4 a = *(const f32x4*)(cw + k * UPW + ch0 + 4 * hlf), b = *(const f32x4*)(cw + k * UPW + DFF + ch0 + 4 * hlf);
#pragma unroll
                for (int j = 0; j < 4; ++j) { wg[k][4 * hlf + j] = a[j]; wv[k][4 * hlf + j] = b[j]; } }
#pragma unroll
        for (int hlf = 0; hlf < 2; ++hlf) { const f32x4 a = *(const f32x4*)(cb + ch0 + 4 * hlf), b = *(const f32x4*)(cb + DFF + ch0 + 4 * hlf);
#pragma unroll
            for (int j = 0; j < 4; ++j) { bg[4 * hlf + j] = a[j]; bv[4 * hlf + j] = b[j]; } }
        const int row0 = u.pm * 256 + wr * 64 + fr;
#pragma unroll
        for (int ai = 0; ai < 2; ++ai) { const int g4 = 2 * ai + wr;
            u32x4 xpg = {0u, 0u, 0u, 0u}, xpv = xpg, xng = xpg, xnv = xpg;
            if (g4 > 0) { const unsigned* d = xbuf + (((((g4 - 1) * 2 + 1) * 4 + wc) * 4 + fq) * 8); xpg = *(const u32x4*)d; xpv = *(const u32x4*)(d + 4); }
            if (g4 < 3) { const unsigned* d = xbuf + (((((g4 + 1) * 2 + 0) * 4 + wc) * 4 + fq) * 8); xng = *(const u32x4*)d; xnv = *(const u32x4*)(d + 4); }
#pragma unroll
            for (int m = 0; m < 4; ++m) {
                unsigned pg[4], pv[4], ng[4], nv[4];
#pragma unroll
                for (int e = 0; e < 4; ++e) {
                    const unsigned sg = (m > 0 && fr == 15) ? G[ai][m > 0 ? m - 1 : 0][e] : G[ai][m][e], sv = (m > 0 && fr == 15) ? V[ai][m > 0 ? m - 1 : 0][e] : V[ai][m][e];
                    const unsigned tg = (m < 3 && fr == 0) ? G[ai][m < 3 ? m + 1 : 3][e] : G[ai][m][e], tv = (m < 3 && fr == 0) ? V[ai][m < 3 ? m + 1 : 3][e] : V[ai][m][e];
                    pg[e] = (unsigned)__builtin_amdgcn_mov_dpp((int)sg, 0x121, 0xf, 0xf, false); pv[e] = (unsigned)__builtin_amdgcn_mov_dpp((int)sv, 0x121, 0xf, 0xf, false);
                    ng[e] = (unsigned)__builtin_amdgcn_mov_dpp((int)tg, 0x12F, 0xf, 0xf, false); nv[e] = (unsigned)__builtin_amdgcn_mov_dpp((int)tv, 0x12F, 0xf, 0xf, false);
                    if (m == 0) { pg[e] = fr == 0 ? xpg[e] : pg[e]; pv[e] = fr == 0 ? xpv[e] : pv[e]; }
                    if (m == 3) { ng[e] = fr == 15 ? xng[e] : ng[e]; nv[e] = fr == 15 ? xnv[e] : nv[e]; }
                }
                float o[8];
#pragma unroll
                for (int e = 0; e < 4; ++e) {
                    const float g_lo = bg[2 * e] + wg[0][2 * e] * bflo(pg[e]) + wg[1][2 * e] * bflo(G[ai][m][e]) + wg[2][2 * e] * bflo(ng[e]);
                    const float g_hi = bg[2 * e + 1] + wg[0][2 * e + 1] * bfhi(pg[e]) + wg[1][2 * e + 1] * bfhi(G[ai][m][e]) + wg[2][2 * e + 1] * bfhi(ng[e]);
                    const float v_lo = bv[2 * e] + wv[0][2 * e] * bflo(pv[e]) + wv[1][2 * e] * bflo(V[ai][m][e]) + wv[2][2 * e] * bflo(nv[e]);
                    const float v_hi = bv[2 * e + 1] + wv[0][2 * e + 1] * bfhi(pv[e]) + wv[1][2 * e + 1] * bfhi(V[ai][m][e]) + wv[2][2 * e + 1] * bfhi(nv[e]);
                    o[2 * e] = siluf_(g_lo) * v_lo; o[2 * e + 1] = siluf_(g_hi) * v_hi; }
                *(u32x4*)(act + (size_t)(row0 + ai * 128 + m * 16) * DFF + ch0) = pack8(o);
            }
        }
    }
};
__device__ __forceinline__ void ffn_fixup_phase(const Ctx& P, int layer) {
    unsigned char* ws = P.ws(); const bf16_t* edge = (const bf16_t*)(ws + W_EDGE); bf16_t* act = (bf16_t*)(ws + R_UP);
    const float* cw = P.in(I_FFN_CW) + (size_t)layer * 3 * UPW; const float* cb = P.in(I_FFN_CB) + (size_t)layer * UPW;
    constexpr int NCG = DFF / 8, NT = M_TOK / 256;
    for (int it = blockIdx.x * 512 + ltid(); it < NT * 2 * NCG; it += gridDim.x * 512) {
        const int cgi = it % NCG, t2 = it / NCG, pm = t2 >> 1, which = t2 & 1, c0 = cgi * 8, row = pm * 256 + (which ? 255 : 0);
        const u32x4 zz = {0u, 0u, 0u, 0u}; u32x4 pg = zz, pv = zz, ng = zz, nv = zz;
        const bf16_t* e0 = edge + (size_t)(pm * 4) * 2 * DFF + c0;
        const int jc = which ? 3 : 0;
        const u32x4 cg_ = *(const u32x4*)(e0 + (size_t)jc * 2 * DFF), cv = *(const u32x4*)(e0 + (size_t)jc * 2 * DFF + DFF);
        if (which) { pg = *(const u32x4*)(e0 + (size_t)2 * 2 * DFF); pv = *(const u32x4*)(e0 + (size_t)2 * 2 * DFF + DFF);
            if (!tok_last(row)) { ng = *(const u32x4*)(e0 + (size_t)4 * 2 * DFF); nv = *(const u32x4*)(e0 + (size_t)4 * 2 * DFF + DFF); } }
        else { ng = *(const u32x4*)(e0 + (size_t)1 * 2 * DFF); nv = *(const u32x4*)(e0 + (size_t)1 * 2 * DFF + DFF);
            if (!tok_first(row)) { pg = *(const u32x4*)(e0 - (size_t)1 * 2 * DFF); pv = *(const u32x4*)(e0 - (size_t)1 * 2 * DFF + DFF); } }
        float a0[8], a1[8], a2[8], b0[8], b1[8], b2[8], o[8];
        unpack8(pg, a0); unpack8(cg_, a1); unpack8(ng, a2); unpack8(pv, b0); unpack8(cv, b1); unpack8(nv, b2);
#pragma unroll
        for (int hlf = 0; hlf < 2; ++hlf) {
            const f32x4 w0g = *(const f32x4*)(cw + c0 + 4 * hlf), w1g = *(const f32x4*)(cw + UPW + c0 + 4 * hlf), w2g = *(const f32x4*)(cw + 2 * UPW + c0 + 4 * hlf), bgv = *(const f32x4*)(cb + c0 + 4 * hlf);
            const f32x4 w0v = *(const f32x4*)(cw + DFF + c0 + 4 * hlf), w1v = *(const f32x4*)(cw + UPW + DFF + c0 + 4 * hlf), w2v = *(const f32x4*)(cw + 2 * UPW + DFF + c0 + 4 * hlf), bvv = *(const f32x4*)(cb + DFF + c0 + 4 * hlf);
#pragma unroll
            for (int j = 0; j < 4; ++j) { const int q = 4 * hlf + j; const float gt = bgv[j] + w0g[j] * a0[q] + w1g[j] * a1[q] + w2g[j] * a2[q]; const float vl = bvv[j] + w0v[j] * b0[q] + w1v[j] * b1[q] + w2v[j] * b2[q]; o[q] = siluf_(gt) * vl; } }
        *(u32x4*)(act + (size_t)row * DFF + c0) = pack8(o);
    }
}
template <class Epi> __device__ __forceinline__ void run_gemm(unsigned char* shm, const bf16_t* A, const bf16_t* Bt, int M, int N, int K, const Epi& E) {
    asm volatile("" : "+s"(M), "+s"(N), "+s"(K));
    pg8::Gemm g; g.A = A; g.Bt = Bt; g.M = M; g.N = N; g.K = K;
    pg8::StaticOrder S; S.init(M, N, (int)gridDim.x, (int)blockIdx.x);
    pg8::gemm_phase<Epi, pg8::StaticOrder, GEMM_ALIGN_EPI, GEMM_SP2>((PG8_LAS unsigned char*)shm, g, S, E);
}

__device__ __forceinline__ void tr_job(const float* W, int K, int N, int NP, const float* scale, bf16_t* dst, float* tile, bool permup) {
    int tid_ = ltid(); const int tid = tid_, nnb = NP / 64, nt = (K / 64) * nnb;
    for (int t = blockIdx.x; t < nt; t += gridDim.x) {
        const int kb = t / nnb, nb = t % nnb, k0 = kb * 64, n0 = nb * 64;
#pragma unroll
        for (int i = 0; i < 8; ++i) { const int kk = i * 8 + (tid >> 6), n = n0 + (tid & 63); float v = (n < N) ? W[(size_t)(k0 + kk) * N + n] : 0.f; if (scale) v *= scale[k0 + kk]; tile[kk * 65 + (tid & 63)] = v; }
        __syncthreads();
        { const int nn = tid >> 3, c = tid & 7; const float* s = tile + (8 * c) * 65 + nn;
          u32x4 o; o.x = pk2(s[0], s[65]); o.y = pk2(s[130], s[195]); o.z = pk2(s[260], s[325]); o.w = pk2(s[390], s[455]);
          int nrow = n0 + nn; if (permup) { const int hv = nrow >= DFF ? 1 : 0, chn = nrow - hv * DFF; nrow = (chn >> 7) * 256 + hv * 128 + (chn & 127); }
          *(u32x4*)(dst + (size_t)nrow * K + k0 + 8 * c) = o; }
        __syncthreads();
    }
}
__device__ __forceinline__ void prep_weights(const Ctx& P, int layer, unsigned char* shm) {
    unsigned char* ws = P.ws(); float* tile = (float*)shm; int tid_ = ltid(); const int tid = tid_, lane = tid & 63, wave = tid >> 6;
#pragma unroll 1
    for (int job = 0; job < 7; ++job) {
        const float* W; const float* sc = nullptr; int K, N, NP; bf16_t* dst;
        if (job == 0) { W = P.in(I_FFN_UP) + (size_t)layer * 1024 * UPW; K = 1024; N = UPW; NP = UPW; sc = P.in(I_NORM_FFN) + layer * 1024; dst = (bf16_t*)(ws + woff(W_WUP, layer)); }
        else if (job == 1) { W = P.in(I_FFN_DOWN) + (size_t)layer * DFF * 1024; K = DFF; N = 1024; NP = 1024; dst = (bf16_t*)(ws + woff(W_WDOWN, layer)); }
        else if (job == 2) { W = P.in(I_W_IN) + (size_t)layer * 1024 * INW; K = 1024; N = INW; NP = INP; sc = P.in(I_NORM_MIX) + layer * 1024; dst = (bf16_t*)(ws + woff(W_WIN, layer)); }
        else if (job == 3) { W = P.in(I_W_OUT) + (size_t)layer * 1024 * 1024; K = 1024; N = 1024; NP = 1024; dst = (bf16_t*)(ws + woff(W_WOUT, layer)); }
        else if (job == 4) { W = P.in(I_PLE_GATE) + (size_t)layer * 1024 * 1024; K = 1024; N = 1024; NP = 1024; sc = P.in(I_PLE_NORM) + layer * 1024; dst = (bf16_t*)(ws + woff(W_WG, layer)); }
        else if (job == 5) { W = P.in(I_PLE_PROJ) + (size_t)layer * 256 * 1024; K = 256; N = 1024; NP = 1024; dst = (bf16_t*)(ws + woff(W_WP, layer)); }
        else { W = P.in(I_S5_GLUW) + (size_t)layer * 256 * 256; K = 256; N = 256; NP = 256; dst = (bf16_t*)(ws + woff(W_GLU, layer)); }
        tr_job(W, K, N, NP, sc, dst, tile, job == 0);
    }
    const size_t gtid = (size_t)blockIdx.x * 512 + tid, gthreads = (size_t)gridDim.x * 512;
    {
        const float* src = P.in(I_SGU_W) + (size_t)layer * 65536; bf16_t* dst = (bf16_t*)(ws + woff(W_SGU, layer));
        for (size_t i = gtid; i < 65536 / 8; i += gthreads) { const f32x4 a = *(const f32x4*)(src + i * 8), b = *(const f32x4*)(src + i * 8 + 4);
            u32x4 o; o.x = pk2(a[0], a[1]); o.y = pk2(a[2], a[3]); o.z = pk2(b[0], b[1]); o.w = pk2(b[2], b[3]); *(u32x4*)(dst + i * 8) = o; }
    }
    {
        f32x2v* ab = (f32x2v*)(ws + woff(W_AB, layer)); f32x2v* abL = (f32x2v*)(ws + woff(W_ABL, layer)); bf16_t* bop = (bf16_t*)(ws + woff(W_BOP, layer)); bf16_t* cop = (bf16_t*)(ws + woff(W_COP, layer));
        for (int it = blockIdx.x; it < 32; it += gridDim.x) { const int k = it >> 4, g = it & 15, p = tid & 63, q = tid >> 6;
            const float step = expf(P.in(I_S5_LSTEP)[(layer * 2 + k) * 16 + g]);
            const float lr = P.in(I_S5_LRE)[((size_t)(layer * 2 + k) * 16 + g) * 64 + p], li = P.in(I_S5_LIM)[((size_t)(layer * 2 + k) * 16 + g) * 64 + p];
            const float mag = expf(lr * step); const float rev = li * step * 0.15915494309189535f; const float fr1 = rev - floorf(rev);
            const float abr = mag * __builtin_amdgcn_cosf(fr1), abi = mag * __builtin_amdgcn_sinf(fr1);
            const float den = lr * lr + li * li; const float f_re = ((abr - 1.0f) * lr + abi * li) / den, f_im = (abi * lr - (abr - 1.0f) * li) / den;
            if (q == 0) { f32x2v t; t.x = abr; t.y = abi; ab[(k * 16 + g) * 64 + p] = t;
                const float magL = expf(lr * step * 128.0f); const float revL = rev * 128.0f; const float frL = revL - floorf(revL);
                f32x2v tl; tl.x = magL * __builtin_amdgcn_cosf(frL); tl.y = magL * __builtin_amdgcn_sinf(frL); abL[(k * 16 + g) * 64 + p] = tl; }
#pragma unroll
            for (int cc = 0; cc < 2; ++cc) { const int c = 2 * q + cc;
                const float br = P.in(I_S5_BRE)[(((size_t)layer * 16 + g) * 64 + p) * 16 + c], bi = P.in(I_S5_BIM)[(((size_t)layer * 16 + g) * 64 + p) * 16 + c];
                bop[((size_t)(k * 16 + g) * 128 + p) * 16 + c] = f2bf(f_re * br - f_im * bi);
                bop[((size_t)(k * 16 + g) * 128 + 64 + p) * 16 + c] = f2bf(f_re * bi + f_im * br); }
            if (k == 0) {
#pragma unroll
                for (int j = 0; j < 4; ++j) { const int e = tid * 4 + j, i = e >> 7, kk = e & 127;
                    const float v = kk < 64 ? P.in(I_S5_CRE)[(((size_t)layer * 16 + g) * 16 + i) * 64 + kk] : -P.in(I_S5_CIM)[(((size_t)layer * 16 + g) * 16 + i) * 64 + (kk - 64)];
                    cop[((size_t)g * 16 + i) * 128 + kk] = f2bf(v); }
            }
        }
    }
}
__device__ __forceinline__ void pconv_phase(const Ctx& P, int layer) {
    unsigned char* ws = P.ws(); const int tid = ltid(); const size_t gtid = (size_t)blockIdx.x * 512 + tid, gthreads = (size_t)gridDim.x * 512;
    {
        bf16_t* dst = (bf16_t*)(ws + W_PBF);
        for (size_t i = gtid; i < (size_t)M_TOK * 32; i += gthreads) { const int row = (int)(i >> 5), cgi = (int)(i & 31);
            const float* src = row < MP ? P.in(I_PP) + ((size_t)layer * MP + row) * 256 : P.in(I_PS) + ((size_t)layer * (M_TOK - MP) + (row - MP)) * 256;
            const f32x4 a = *(const f32x4*)(src + cgi * 8), b = *(const f32x4*)(src + cgi * 8 + 4);
            u32x4 o; o.x = pk2(a[0], a[1]); o.y = pk2(a[2], a[3]); o.z = pk2(b[0], b[1]); o.w = pk2(b[2], b[3]); *(u32x4*)(dst + (size_t)row * 256 + cgi * 8) = o; }
    }
}
__device__ __forceinline__ void xinit_phase(const Ctx& P) {
    unsigned char* ws = P.ws(); const int tid = ltid(), lane = tid & 63, wave = tid >> 6;
    {
        bf16_t* xb = (bf16_t*)P.out(); float* part = (float*)(ws + W_PARTA);
        for (int row = blockIdx.x * 8 + wave; row < M_TOK; row += gridDim.x * 8) {
            const float* src = row < MP ? P.in(I_XP) + (size_t)row * 1024 : P.in(I_XS) + (size_t)(row - MP) * 1024;
            float ss = 0.f;
#pragma unroll
            for (int j = 0; j < 4; ++j) { const f32x4 v = ((const f32x4*)src)[lane + 64 * j];
                u32x2 w; w.x = pk2(v[0], v[1]); w.y = pk2(v[2], v[3]); ((u32x2*)(xb + (size_t)row * 1024))[lane + 64 * j] = w;
                ss += (v[0] * v[0] + v[1] * v[1]) + (v[2] * v[2] + v[3] * v[3]); }
            ss += __shfl_xor(ss, 1); ss += __shfl_xor(ss, 2);
            if ((lane & 3) == 0) part[(size_t)row * 16 + (lane >> 2)] = ss;
        }
    }
}

template <bool TR, int LG, int LD = 136> __device__ __forceinline__ void conv_silu_tile(const bf16_t* proj, int t0, bool hp, bool hn, int cc0, const float* cw, const float* cb, bf16_t* dst) {
    constexpr int NG = 1 << LG;
    constexpr int NQ = TR ? (NG / 8) : 1, NL = TR ? 2 : 4;
    const int tid = ltid();
    u32x4 rc[2][NL], rp[2][NL], rn[2][NL];
#define CST_LOAD(q_, s_) do { const int cc_ = cc0 + (TR ? ((tid >> 6) + 8 * (q_)) : (tid & 15)) * 8; \
        _Pragma("unroll") for (int i_ = 0; i_ < NL; ++i_) { const int l_ = TR ? ((tid & 63) + 64 * i_) : ((tid >> 4) + 32 * i_); const bf16_t* base_ = proj + (size_t)(t0 + l_) * INW + O_XBC + cc_; \
            const bool vp_ = (l_ > 0) | hp, vn_ = (l_ < 127) | hn; const u32x4 zz_ = {0u, 0u, 0u, 0u}; \
            rc[s_][i_] = *(const u32x4*)base_; const u32x4 tp_ = *(const u32x4*)(base_ - (vp_ ? INW : 0)), tn_ = *(const u32x4*)(base_ + (vn_ ? INW : 0)); rp[s_][i_] = vp_ ? tp_ : zz_; rn[s_][i_] = vn_ ? tn_ : zz_; } } while (0)
    CST_LOAD(0, 0);
#pragma unroll
    for (int q = 0; q < NQ; ++q) {
        const int cgi = TR ? ((tid >> 6) + 8 * q) : (tid & 15);
        const int cc = cc0 + cgi * 8;
        float w0[8], w1[8], w2[8], bb[8];
#pragma unroll
        for (int hlf = 0; hlf < 2; ++hlf) { const f32x4 a = *(const f32x4*)(cw + cc + 4 * hlf), b = *(const f32x4*)(cw + 1024 + cc + 4 * hlf), c = *(const f32x4*)(cw + 2048 + cc + 4 * hlf), d = *(const f32x4*)(cb + cc + 4 * hlf);
#pragma unroll
            for (int j = 0; j < 4; ++j) { w0[4 * hlf + j] = a[j]; w1[4 * hlf + j] = b[j]; w2[4 * hlf + j] = c[j]; bb[4 * hlf + j] = d[j]; } }
        if (q + 1 < NQ) CST_LOAD(q + 1, (q + 1) & 1);
#pragma unroll
        for (int i = 0; i < NL; ++i) {
            const int l = TR ? ((tid & 63) + 64 * i) : ((tid >> 4) + 32 * i);
            float xp[8], xc[8], xn[8], o[8];
            unpack8(rp[q & 1][i], xp); unpack8(rc[q & 1][i], xc); unpack8(rn[q & 1][i], xn);
#pragma unroll
            for (int j = 0; j < 8; ++j) o[j] = siluf_(bb[j] + w0[j] * xp[j] + w1[j] * xc[j] + w2[j] * xn[j]);
            if (TR) {
#pragma unroll
                for (int j = 0; j < 8; ++j) dst[(cgi * 8 + j) * 136 + l] = f2bf(o[j]);
            } else { *(u32x4*)(dst + l * LD + cgi * 8) = pack8(o); }
        }
        if (q + 1 < NQ) asm volatile("" ::: "memory");
    }
#undef CST_LOAD
}

struct XhRegs { u32x4 rc[2], rp[2], rn[2]; };
__device__ __forceinline__ void xh_load(XhRegs& R, const bf16_t* proj, int t0, bool hp, bool hn, int cc0, int tid) {
    const int cc = cc0 + (tid >> 6) * 8;
#pragma unroll
    for (int i = 0; i < 2; ++i) { const int l = (tid & 63) + 64 * i; const bf16_t* base = proj + (size_t)(t0 + l) * INW + O_XBC + cc;
        const bool vp = (l > 0) | hp, vn = (l < 127) | hn; const u32x4 zz = {0u, 0u, 0u, 0u};
        R.rc[i] = *(const u32x4*)base; const u32x4 tp = *(const u32x4*)(base - (vp ? INW : 0)), tn = *(const u32x4*)(base + (vn ? INW : 0)); R.rp[i] = vp ? tp : zz; R.rn[i] = vn ? tn : zz; }
}
__device__ __forceinline__ void xh_store(const XhRegs& R, int cc0, const float* cw, const float* cb, bf16_t* dst, int tid) {
    const int cgi = tid >> 6, cc = cc0 + cgi * 8;
    float w0[8], w1[8], w2[8], bb[8];
#pragma unroll
    for (int hlf = 0; hlf < 2; ++hlf) { const f32x4 a = *(const f32x4*)(cw + cc + 4 * hlf), b = *(const f32x4*)(cw + 1024 + cc + 4 * hlf), c = *(const f32x4*)(cw + 2048 + cc + 4 * hlf), d = *(const f32x4*)(cb + cc + 4 * hlf);
#pragma unroll
        for (int j = 0; j < 4; ++j) { w0[4 * hlf + j] = a[j]; w1[4 * hlf + j] = b[j]; w2[4 * hlf + j] = c[j]; bb[4 * hlf + j] = d[j]; } }
#pragma unroll
    for (int i = 0; i < 2; ++i) { const int l = (tid & 63) + 64 * i; float xp[8], xc[8], xn[8];
        unpack8(R.rp[i], xp); unpack8(R.rc[i], xc); unpack8(R.rn[i], xn);
#pragma unroll
        for (int j = 0; j < 8; ++j) dst[(cgi * 8 + j) * 136 + l] = f2bf(siluf_(bb[j] + w0[j] * xp[j] + w1[j] * xc[j] + w2[j] * xn[j])); }
}

__device__ __forceinline__ void ssd_s1_item(const Ctx& P, int layer, int item, unsigned char* shm) {
    int tid_ = ltid(); const int tid = tid_, lane = tid & 63, wave = tid >> 6, fr = lane & 15, fq = lane >> 4;
    const int chunk = item >> 1, g = item & 1, t0 = chunk * 128;
    const bool hp = !tok_first(t0), hn = !tok_last(t0 + 127);
    unsigned char* ws = P.ws(); const bf16_t* proj = (const bf16_t*)(ws + R_PROJ); const float* dtb = (const float*)(ws + W_DT);
    bf16_t* Bn = (bf16_t*)shm; bf16_t* Xn = (bf16_t*)(shm + 34816); float* WGT = (float*)(shm + 104448);
    const float* cw = P.in(I_SSD_CW) + (size_t)layer * 3 * 1024; const float* cb = P.in(I_SSD_CB) + (size_t)layer * 1024;
    conv_silu_tile<false, 4, 136>(proj, t0, hp, hn, 512 + g * 128, cw, cb, Bn); asm volatile("" ::: "memory");
    conv_silu_tile<false, 4, 264>(proj, t0, hp, hn, g * 256, cw, cb, Xn); asm volatile("" ::: "memory");
    conv_silu_tile<false, 4, 264>(proj, t0, hp, hn, g * 256 + 128, cw, cb, Xn + 128); asm volatile("" ::: "memory");
    const int hh = wave & 3, dir = wave >> 2, h = g * 4 + hh;
    {
        const float bias = P.in(I_SSD_DTB)[(layer * 2 + dir) * 8 + h], a = -expf(P.in(I_SSD_ALOG)[(layer * 2 + dir) * 8 + h]);
        const int l0 = 2 * lane;
        const float d0 = softplusf_(dtb[(size_t)(t0 + l0) * 16 + dir * 8 + h] + bias), d1 = softplusf_(dtb[(size_t)(t0 + l0 + 1) * 16 + dir * 8 + h] + bias);
        const float a0 = d0 * a, a1 = d1 * a;
        const float incl = wave_incl_scan(a0 + a1, lane); const float total = __shfl(incl, 63);
        const float cs1 = incl, cs0 = incl - a1;
        float w0, w1;
        if (dir == 0) { w0 = d0 * __expf(total - cs0); w1 = d1 * __expf(total - cs1); }
        else { w0 = d0 * __expf(cs0 - a0); w1 = d1 * __expf(cs0); }
        WGT[wave * 128 + l0] = w0; WGT[wave * 128 + l0 + 1] = w1;
        if (lane == 0) ((float*)(ws + W_DECAY))[(chunk * 2 + dir) * 8 + h] = __expf(total);
    }
    __syncthreads();
    f32x4 acc[4][8];
#pragma unroll
    for (int i = 0; i < 4; ++i)
#pragma unroll
        for (int j = 0; j < 8; ++j) acc[i][j] = (f32x4){0.f, 0.f, 0.f, 0.f};
#pragma unroll 1
    for (int ks = 0; ks < 4; ++ks) {
        const f32x4 wa = *(const f32x4*)(WGT + wave * 128 + ks * 32 + fq * 8), wb = *(const f32x4*)(WGT + wave * 128 + ks * 32 + fq * 8 + 4);
        bf16x8 af[4];
        const int krow = ks * 32 + 8 * fq + (fr >> 2);
#pragma unroll
        for (int i = 0; i < 4; ++i) { const bf16_t* ap = Xn + krow * 264 + hh * 64 + 16 * i + 4 * (fr & 3);
            const s16x4 r0 = lds_tr4(ap), r1 = lds_tr4(ap + 4 * 264);
            u32x4 s; s.x = pk2(bf2f((bf16_t)r0[0]) * wa[0], bf2f((bf16_t)r0[1]) * wa[1]); s.y = pk2(bf2f((bf16_t)r0[2]) * wa[2], bf2f((bf16_t)r0[3]) * wa[3]);
            s.z = pk2(bf2f((bf16_t)r1[0]) * wb[0], bf2f((bf16_t)r1[1]) * wb[1]); s.w = pk2(bf2f((bf16_t)r1[2]) * wb[2], bf2f((bf16_t)r1[3]) * wb[3]);
            af[i] = __builtin_bit_cast(bf16x8, s); }
#pragma unroll
        for (int j = 0; j < 8; ++j) { const bf16_t* bp = Bn + krow * 136 + 32 * (j >> 1) + 8 * (fr & 3) + 4 * (j & 1);
            const s16x4 b0 = lds_tr4(bp), b1 = lds_tr4(bp + 4 * 136);
            bf16x8 bfj; bfj[0] = b0[0]; bfj[1] = b0[1]; bfj[2] = b0[2]; bfj[3] = b0[3]; bfj[4] = b1[0]; bfj[5] = b1[1]; bfj[6] = b1[2]; bfj[7] = b1[3];
#pragma unroll
            for (int i = 0; i < 4; ++i) acc[i][j] = MFMA32(bfj, af[i], acc[i][j]); }
    }
    bf16_t* st = (bf16_t*)(ws + R_STATES) + ((size_t)(chunk * 2 + dir) * 8 + h) * 8192;
#pragma unroll
    for (int i = 0; i < 4; ++i)
#pragma unroll
        for (int jj = 0; jj < 4; ++jj) { u32x4 w; w.x = pk2(acc[i][2 * jj][0], acc[i][2 * jj][1]); w.y = pk2(acc[i][2 * jj][2], acc[i][2 * jj][3]); w.z = pk2(acc[i][2 * jj + 1][0], acc[i][2 * jj + 1][1]); w.w = pk2(acc[i][2 * jj + 1][2], acc[i][2 * jj + 1][3]);
            *(u32x4*)(st + (16 * i + fr) * 128 + 32 * jj + 8 * fq) = w; }
    __syncthreads();
}

__device__ __forceinline__ void ssd_scan_item(const Ctx& P, int item) {
    int tid_ = ltid(); const int tid = tid_; unsigned char* ws = P.ws();
    const int sp = item >> 5, rem = item & 31; const int seq = sp < 2 ? 16 + sp : sp - 2; const int dir = rem >> 4, h = (rem >> 1) & 7, ps = rem & 1;
    const int nC = seq < 16 ? 16 : 64, cbase = seq < 16 ? seq * 16 : 256 + (seq - 16) * 64;
    const int p = ps * 32 + (tid >> 4), ng = tid & 15;
    bf16_t* states = (bf16_t*)(ws + R_STATES); const float* decay = (const float*)(ws + W_DECAY);
    float run[8];
#pragma unroll
    for (int j = 0; j < 8; ++j) run[j] = 0.f;
    {
        long sstride = dir == 0 ? (long)(2 * 8 * 8192) : -(long)(2 * 8 * 8192);
        int dstride = dir == 0 ? 16 : -16;
        asm volatile("" : "+v"(sstride), "+v"(dstride));
        const int cfirst = cbase + (dir == 0 ? 0 : nC - 1);
        bf16_t* a0 = states + ((size_t)(cfirst * 2 + dir) * 8 + h) * 8192 + p * 128 + ng * 8;
        const float* d0 = decay + (cfirst * 2 + dir) * 8 + h;
        for (int c8 = 0; c8 < nC; c8 += 8) {
            u32x4 v[8]; float dc[8];
#pragma unroll
            for (int i = 0; i < 8; ++i) { v[i] = *(const u32x4*)(a0 + i * sstride); dc[i] = d0[i * dstride]; }
#pragma unroll
            for (int i = 0; i < 8; ++i) { float sv[8]; unpack8(v[i], sv); if (P.rep == 0) *(u32x4*)(a0 + i * sstride) = pack8(run);
#pragma unroll
                for (int j = 0; j < 8; ++j) run[j] = run[j] * dc[i] + sv[j]; }
            a0 += 8 * sstride; d0 += 8 * dstride;
        }
    }
}

#define S3_PRELOAD(hq) do { xh_load(XR, proj, t0, hp, hn, g * 256 + (hq) * 64, tid); \
        const bf16_t* sf_ = states + ((size_t)(chunk * 2 + 0) * 8 + g * 4 + (hq)) * 8192; const bf16_t* sb_ = states + ((size_t)(chunk * 2 + 1) * 8 + g * 4 + (hq)) * 8192; \
        _Pragma("unroll") for (int i_ = 0; i_ < 2; ++i_) { const int it_ = tid + 512 * i_, p_ = it_ >> 4, c_ = it_ & 15; hfr[i_] = *(const u32x4*)(sf_ + p_ * 128 + c_ * 8); hbr[i_] = *(const u32x4*)(sb_ + p_ * 128 + c_ * 8); } } while (0)
__device__ __forceinline__ void ssd_s3_item(const Ctx& P, int layer, int item, unsigned char* shm) {
    int tid_ = ltid(); const int tid = tid_, lane = tid & 63, wave = tid >> 6, fr = lane & 15, fq = lane >> 4;
    const int chunk = item >> 1, g = item & 1, t0 = chunk * 128;
    const bool hp = !tok_first(t0), hn = !tok_last(t0 + 127);
    unsigned char* ws = P.ws(); const bf16_t* proj = (const bf16_t*)(ws + R_PROJ); const float* dtb = (const float*)(ws + W_DT);
    bf16_t* Cn = (bf16_t*)shm; bf16_t* BW = (bf16_t*)(shm + 34816); bf16_t* xTh = (bf16_t*)(shm + 69632); bf16_t* Hf = (bf16_t*)(shm + 87040); bf16_t* Hb = (bf16_t*)(shm + 104448);
    float* CSF = (float*)(shm + 121856); float* RCS = (float*)(shm + 123904); float* DTF = (float*)(shm + 125952); float* DTB = (float*)(shm + 128000);
    const float* cw = P.in(I_SSD_CW) + (size_t)layer * 3 * 1024; const float* cb = P.in(I_SSD_CB) + (size_t)layer * 1024;
    const bf16_t* states = (const bf16_t*)(ws + R_STATES);
    XhRegs XR; u32x4 hfr[2], hbr[2];
    S3_PRELOAD(0);
    conv_silu_tile<false, 4>(proj, t0, hp, hn, 512 + 256 + g * 128, cw, cb, Cn);
    conv_silu_tile<false, 4>(proj, t0, hp, hn, 512 + g * 128, cw, cb, BW);
    {
        const int hh = wave & 3, dir = wave >> 2, h = g * 4 + hh;
        const float bias = P.in(I_SSD_DTB)[(layer * 2 + dir) * 8 + h], a = -expf(P.in(I_SSD_ALOG)[(layer * 2 + dir) * 8 + h]);
        const int l0 = 2 * lane;
        const float d0 = softplusf_(dtb[(size_t)(t0 + l0) * 16 + dir * 8 + h] + bias), d1 = softplusf_(dtb[(size_t)(t0 + l0 + 1) * 16 + dir * 8 + h] + bias);
        const float a0 = d0 * a, a1 = d1 * a;
        const float incl = wave_incl_scan(a0 + a1, lane); const float total = __shfl(incl, 63);
        const float cs1 = incl, cs0 = incl - a1;
        if (dir == 0) { CSF[hh * 128 + l0] = cs0; CSF[hh * 128 + l0 + 1] = cs1; DTF[hh * 128 + l0] = d0; DTF[hh * 128 + l0 + 1] = d1; }
        else { RCS[hh * 128 + l0] = total - (cs0 - a0); RCS[hh * 128 + l0 + 1] = total - cs0; DTB[hh * 128 + l0] = d0; DTB[hh * 128 + l0 + 1] = d1; }
    }
    __syncthreads();
    const int l = 16 * wave + fr;
    f32x4 cbm[8];
#pragma unroll
    for (int j = 0; j < 8; ++j) cbm[j] = (f32x4){0.f, 0.f, 0.f, 0.f};
#pragma unroll
    for (int ks = 0; ks < 4; ++ks) { const bf16x8 sec = *(const bf16x8*)(Cn + l * 136 + ks * 32 + fq * 8);
#pragma unroll
        for (int j = 0; j < 8; ++j) { const bf16x8 fst = *(const bf16x8*)(BW + (16 * j + fr) * 136 + ks * 32 + fq * 8); cbm[j] = MFMA32(fst, sec, cbm[j]); } }
    __syncthreads();
    float ssq = 0.f;
    bf16_t* mix = (bf16_t*)(ws + R_MIX);
#pragma unroll 1
    for (int hh = 0; hh < 4; ++hh) {
        const int h = g * 4 + hh;
        xh_store(XR, g * 256 + hh * 64, cw, cb, xTh, tid);
#pragma unroll
        for (int i = 0; i < 2; ++i) { const int it = tid + 512 * i, p = it >> 4, c = it & 15; *(u32x4*)(Hf + p * 136 + c * 8) = hfr[i]; *(u32x4*)(Hb + p * 136 + c * 8) = hbr[i]; }
        {
            int lq = l; asm volatile("" : "+v"(lq));
            const float cfl = CSF[hh * 128 + l], rcl = RCS[hh * 128 + l];
#pragma unroll
            for (int j = 0; j < 8; ++j) { float wv[4];
                const int s0 = 16 * j + 4 * fq;
                const f32x4 csf4 = *(const f32x4*)(CSF + hh * 128 + s0), dtf4 = *(const f32x4*)(DTF + hh * 128 + s0), rcs4 = *(const f32x4*)(RCS + hh * 128 + s0), dtb4 = *(const f32x4*)(DTB + hh * 128 + s0);
#pragma unroll
                for (int r = 0; r < 4; ++r) { const int s = s0 + r;
                    const float ef = (s <= lq) ? __expf(cfl - csf4[r]) * dtf4[r] : 0.f;
                    const float eb = (s >= lq) ? __expf(rcl - rcs4[r]) * dtb4[r] : 0.f;
                    wv[r] = cbm[j][r] * (ef + eb); }
                u32x2 w; w.x = pk2(wv[0], wv[1]); w.y = pk2(wv[2], wv[3]); *(u32x2*)(BW + l * 136 + 16 * j + 4 * fq) = w; }
        }
        __syncthreads();
        if (hh < 3) S3_PRELOAD(hh + 1);
        f32x4 ya[4], tf[4], tb[4];
#pragma unroll
        for (int j = 0; j < 4; ++j) { ya[j] = (f32x4){0.f, 0.f, 0.f, 0.f}; tf[j] = ya[j]; tb[j] = ya[j]; }
#pragma unroll
        for (int ks = 0; ks < 4; ++ks) {
            const bf16x8 secC = *(const bf16x8*)(Cn + l * 136 + ks * 32 + fq * 8), secW = *(const bf16x8*)(BW + l * 136 + ks * 32 + fq * 8);
#pragma unroll
            for (int j = 0; j < 4; ++j) {
                const bf16x8 f1 = *(const bf16x8*)(Hf + prow(j, fr) * 136 + ks * 32 + fq * 8), f2 = *(const bf16x8*)(Hb + prow(j, fr) * 136 + ks * 32 + fq * 8), f3 = *(const bf16x8*)(xTh + prow(j, fr) * 136 + ks * 32 + fq * 8);
                tf[j] = MFMA32(f1, secC, tf[j]); tb[j] = MFMA32(f2, secC, tb[j]); ya[j] = MFMA32(f3, secW, ya[j]); }
        }
        {
            const float ef = __expf(CSF[hh * 128 + l]), eb = __expf(RCS[hh * 128 + l]), dsk = P.in(I_SSD_D)[layer * 8 + h];
#pragma unroll
            for (int jj = 0; jj < 2; ++jj) { const int p0 = 32 * jj + 8 * fq;
                float z[8], yv[8]; unpack8(*(const u32x4*)(proj + (size_t)(t0 + l) * INW + h * 64 + p0), z);
#pragma unroll
                for (int e = 0; e < 8; ++e) { const int j = 2 * jj + (e >> 2), r = e & 3; const float xs = bf2f(xTh[(p0 + e) * 136 + l]);
                    const float y = ya[j][r] + tf[j][r] * ef + tb[j][r] * eb + dsk * xs; yv[e] = y * siluf_(z[e]); ssq += yv[e] * yv[e]; }
                *(u32x4*)(mix + (size_t)(t0 + l) * 1024 + h * 64 + p0) = pack8(yv); }
        }
        __syncthreads();
    }
    ssq += __shfl_xor(ssq, 16); ssq += __shfl_xor(ssq, 32);
    if (fq == 0) ((float*)(ws + W_SSQ))[(size_t)(t0 + l) * 2 + g] = ssq;
}

template <bool FULL> __device__ __forceinline__ void s5_item(const Ctx& P, int layer, int item, unsigned char* shm) {
    int tid_ = ltid(); const int tid = tid_, lane = tid & 63, wave = tid >> 6, fr = lane & 15, fq = lane >> 4;
    const int sq = item >> 2, k = (item >> 1) & 1, g = (item & 1) * 8 + wave;
    unsigned char* ws = P.ws(); const bf16_t* proj = (const bf16_t*)(ws + R_PROJ);
    const f32x2v* ab = (const f32x2v*)(ws + woff(W_AB, layer)); const bf16_t* bop = (const bf16_t*)(ws + woff(W_BOP, layer)); const bf16_t* cop = (const bf16_t*)(ws + woff(W_COP, layer));
    bf16_t* S = (bf16_t*)(shm + wave * 4352);
    float are[4], aim[4], sre[4], sim[4]; bf16x4 bre[4], bim[4]; bf16x8 cf[4];
    const int seg = sq * 4 + fq;
#pragma unroll
    for (int j = 0; j < 4; ++j) { const f32x2v t = ab[(k * 16 + g) * 64 + 16 * j + fr]; are[j] = t.x; aim[j] = t.y;
        bre[j] = *(const bf16x4*)(bop + ((size_t)(k * 16 + g) * 128 + 16 * j + fr) * 16 + fq * 4);
        bim[j] = *(const bf16x4*)(bop + ((size_t)(k * 16 + g) * 128 + 64 + 16 * j + fr) * 16 + fq * 4);
        if (FULL) { cf[j] = *(const bf16x8*)(cop + ((size_t)g * 16 + fr) * 128 + j * 32 + fq * 8);
            const f32x2v hi = ((const f32x2v*)(ws + W_HIN))[((size_t)(seg * 2 + k) * 16 + g) * 64 + 16 * j + fr]; sre[j] = hi.x; sim[j] = hi.y; }
        else { sre[j] = 0.f; sim[j] = 0.f; } }
    const int qa = fr >> 2, ra = fr & 3;
    const bf16_t* abase = proj + O_S5 + g * 16 + fq * 4;
    const int tokA0 = (sq * 4 + qa) * 128;
    bf16_t* yb = (bf16_t*)(ws + R_S5Y) + (size_t)k * M_TOK * 256 + g * 16 + fr;
    bf16x4 afr = *(const bf16x4*)(abase + (size_t)(tokA0 + (k == 0 ? ra : 127 - ra)) * INW);
    for (int tb = 0; tb < 32; ++tb) {
        const bf16x4 acur = afr;
        if (tb < 31) { const int tau = (tb + 1) * 4 + ra; afr = *(const bf16x4*)(abase + (size_t)(tokA0 + (k == 0 ? tau : 127 - tau)) * INW); }
        f32x4 ure[4], uim[4];
#pragma unroll
        for (int j = 0; j < 4; ++j) { ure[j] = MFMA16(acur, bre[j], ((f32x4){0.f, 0.f, 0.f, 0.f})); uim[j] = MFMA16(acur, bim[j], ((f32x4){0.f, 0.f, 0.f, 0.f})); }
#pragma unroll
        for (int r = 0; r < 4; ++r)
#pragma unroll
            for (int j = 0; j < 4; ++j) { const float nre = are[j] * sre[j] - aim[j] * sim[j] + ure[j][r], nim = are[j] * sim[j] + aim[j] * sre[j] + uim[j][r]; sre[j] = nre; sim[j] = nim;
                if (FULL) { S[(4 * fq + r) * 136 + 16 * j + fr] = f2bf(nre); S[(4 * fq + r) * 136 + 64 + 16 * j + fr] = f2bf(nim); } }
        if (FULL) {
            WAVE_LDS_FENCE();
            f32x4 ya = (f32x4){0.f, 0.f, 0.f, 0.f};
#pragma unroll
            for (int ks = 0; ks < 4; ++ks) { const bf16x8 a2 = *(const bf16x8*)(S + fr * 136 + ks * 32 + fq * 8); ya = MFMA32(a2, cf[ks], ya); }
            WAVE_LDS_FENCE();
#pragma unroll
            for (int r = 0; r < 4; ++r) { const int tau = tb * 4 + r; const int tok = seg * 128 + (k == 0 ? tau : 127 - tau); yb[(size_t)tok * 256] = f2bf(ya[r]); }
        }
    }
    if (!FULL) {
        f32x2v* hl = (f32x2v*)(ws + W_HLOC);
#pragma unroll
        for (int j = 0; j < 4; ++j) { f32x2v t; t.x = sre[j]; t.y = sim[j]; hl[((size_t)(seg * 2 + k) * 16 + g) * 64 + 16 * j + fr] = t; }
    }
}
__device__ __forceinline__ void s5_carry(const Ctx& P, int layer) {
    unsigned char* ws = P.ws(); const f32x2v* abL = (const f32x2v*)(ws + woff(W_ABL, layer)); const f32x2v* hl = (const f32x2v*)(ws + W_HLOC); f32x2v* hin = (f32x2v*)(ws + W_HIN);
    for (int idx = blockIdx.x * 512 + ltid(); idx < 18 * 2048; idx += gridDim.x * 512) {
        const int p = idx & 63, g = (idx >> 6) & 15, k = (idx >> 10) & 1, seq = idx >> 11;
        const int nS = seq < 16 ? 16 : 64, sbase = seq < 16 ? seq * 16 : 256 + (seq - 16) * 64;
        const f32x2v a = abL[(k * 16 + g) * 64 + p]; float rr = 0.f, ri = 0.f;
        for (int s = 0; s < nS; ++s) { const int sg = sbase + (k == 0 ? s : nS - 1 - s); const size_t o = ((size_t)(sg * 2 + k) * 16 + g) * 64 + p;
            const f32x2v v = hl[o]; f32x2v t; t.x = rr; t.y = ri; hin[o] = t;
            const float nr = a.x * rr - a.y * ri + v.x, ni = a.x * ri + a.y * rr + v.y; rr = nr; ri = ni; }
    }
}

__device__ __forceinline__ void sgu_item(const Ctx& P, int layer, int chunk, unsigned char* shm) {
    int tid_ = ltid(); const int tid = tid_, lane = tid & 63, wave = tid >> 6, fr = lane & 15, fq = lane >> 4, t0 = chunk * 128;
    unsigned char* ws = P.ws(); const bf16_t* proj = (const bf16_t*)(ws + R_PROJ); bf16_t* vT = (bf16_t*)shm;
    {
        const int l = tid >> 2, part = tid & 3; const bf16_t* src = proj + (size_t)(t0 + l) * INW + O_SGU + 256 + part * 64;
        float v[64]; float s = 0.f;
#pragma unroll
        for (int i = 0; i < 8; ++i) { float t[8]; unpack8(*(const u32x4*)(src + i * 8), t);
#pragma unroll
            for (int j = 0; j < 8; ++j) { v[i * 8 + j] = geluf_(t[j]); s += v[i * 8 + j]; } }
        s += __shfl_xor(s, 1); s += __shfl_xor(s, 2); const float mean = s * (1.0f / 256.0f); float q = 0.f;
#pragma unroll
        for (int i = 0; i < 64; ++i) { v[i] -= mean; q += v[i] * v[i]; }
        q += __shfl_xor(q, 1); q += __shfl_xor(q, 2); const float rstd = rsqrtf(q * (1.0f / 256.0f) + 1e-5f);
        const float* nw = P.in(I_SGU_NW) + layer * 256 + part * 64; const float* nb = P.in(I_SGU_NB) + layer * 256 + part * 64;
#pragma unroll
        for (int i = 0; i < 64; ++i) vT[(part * 64 + i) * 136 + l] = f2bf(v[i] * rstd * nw[i] + nb[i]);
    }
    __syncthreads();
    const int t = 16 * wave + fr; const bf16_t* Wsg = (const bf16_t*)(ws + woff(W_SGU, layer));
    f32x4 acc[4][4];
#pragma unroll
    for (int h = 0; h < 4; ++h)
#pragma unroll
        for (int j = 0; j < 4; ++j) acc[h][j] = (f32x4){0.f, 0.f, 0.f, 0.f};
#pragma unroll
    for (int h = 0; h < 4; ++h)
#pragma unroll
        for (int ks = 0; ks < 4; ++ks) { const bf16x8 sec = *(const bf16x8*)(Wsg + ((size_t)h * 128 + t) * 128 + ks * 32 + fq * 8);
#pragma unroll
            for (int j = 0; j < 4; ++j) { const bf16x8 fst = *(const bf16x8*)(vT + (h * 64 + 16 * j + fr) * 136 + ks * 32 + fq * 8); acc[h][j] = MFMA32(fst, sec, acc[h][j]); } }
    float ss = 0.f;
#pragma unroll
    for (int h = 0; h < 4; ++h) { const float bs = P.in(I_SGU_B)[(layer * 4 + h) * 128 + t];
#pragma unroll
        for (int j = 0; j < 4; ++j) { const int ch = h * 64 + 16 * j + 4 * fq; const u32x2 uw = *(const u32x2*)(proj + (size_t)(t0 + t) * INW + O_SGU + ch);
            const float u0 = geluf_(bflo(uw.x)), u1 = geluf_(bfhi(uw.x)), u2 = geluf_(bflo(uw.y)), u3 = geluf_(bfhi(uw.y));
            f32x4 o; o[0] = u0 * (acc[h][j][0] + bs); o[1] = u1 * (acc[h][j][1] + bs); o[2] = u2 * (acc[h][j][2] + bs); o[3] = u3 * (acc[h][j][3] + bs);
            acc[h][j] = o; ss += (o[0] * o[0] + o[1] * o[1]) + (o[2] * o[2] + o[3] * o[3]); } }
    ss += __shfl_xor(ss, 16); ss += __shfl_xor(ss, 32);
    const float rstd = rsqrtf(ss * (1.0f / 256.0f) + 1e-6f); bf16_t* mix = (bf16_t*)(ws + R_MIX); const float* onw = P.in(I_SGU_ONORM) + layer * 256;
#pragma unroll
    for (int h = 0; h < 4; ++h)
#pragma unroll
        for (int j = 0; j < 4; ++j) { const int ch = h * 64 + 16 * j + 4 * fq; const f32x4 w4 = *(const f32x4*)(onw + ch); const f32x4 o = acc[h][j];
            u32x2 w; w.x = pk2(o[0] * rstd * w4[0], o[1] * rstd * w4[1]); w.y = pk2(o[2] * rstd * w4[2], o[3] * rstd * w4[3]); *(u32x2*)(mix + (size_t)(t0 + t) * 1024 + 768 + ch) = w; }
    __syncthreads();
}

__device__ __forceinline__ void finalize_item(const Ctx& P, int layer, int tile, unsigned char* shm) {
    int tid_ = ltid(); const int tid = tid_, lane = tid & 63, wave = tid >> 6, fr = lane & 15, fq = lane >> 4, t0 = tile * 128;
    unsigned char* ws = P.ws(); const bf16_t* proj = (const bf16_t*)(ws + R_PROJ); bf16_t* mix = (bf16_t*)(ws + R_MIX);
    {
        const float* ssq = (const float*)(ws + W_SSQ); const float* nw = P.in(I_SSD_NORM) + layer * 512;
#pragma unroll 4
        for (int i = 0; i < 16; ++i) { const int it = tid + 512 * i, l = it >> 6, cgi = it & 63;
            const float rstd = rsqrtf((ssq[(size_t)(t0 + l) * 2] + ssq[(size_t)(t0 + l) * 2 + 1]) * (1.0f / 512.0f) + 1e-6f);
            bf16_t* ptr = mix + (size_t)(t0 + l) * 1024 + cgi * 8; float v[8]; unpack8(*(const u32x4*)ptr, v);
            const f32x4 wa = *(const f32x4*)(nw + cgi * 8), wb = *(const f32x4*)(nw + cgi * 8 + 4);
            v[0] *= rstd * wa[0]; v[1] *= rstd * wa[1]; v[2] *= rstd * wa[2]; v[3] *= rstd * wa[3]; v[4] *= rstd * wb[0]; v[5] *= rstd * wb[1]; v[6] *= rstd * wb[2]; v[7] *= rstd * wb[3];
            if (P.rep == 0) *(u32x4*)ptr = pack8(v); }
    }
    bf16_t* Yg = (bf16_t*)shm;
    {
        const bf16_t* yf = (const bf16_t*)(ws + R_S5Y); const bf16_t* ybk = yf + (size_t)M_TOK * 256; const float* dsk = P.in(I_S5_D) + layer * 256;
#pragma unroll 2
        for (int i = 0; i < 8; ++i) { const int it = tid + 512 * i, l = it >> 5, cgi = it & 31;
            float u[8], a[8], b[8], o[8]; unpack8(*(const u32x4*)(proj + (size_t)(t0 + l) * INW + O_S5 + cgi * 8), u);
            unpack8(*(const u32x4*)(yf + (size_t)(t0 + l) * 256 + cgi * 8), a); unpack8(*(const u32x4*)(ybk + (size_t)(t0 + l) * 256 + cgi * 8), b);
            const f32x4 da = *(const f32x4*)(dsk + cgi * 8), db = *(const f32x4*)(dsk + cgi * 8 + 4);
#pragma unroll
            for (int j = 0; j < 8; ++j) o[j] = geluf_(u[j] * (j < 4 ? da[j & 3] : db[j & 3]) + a[j] + b[j]);
            *(u32x4*)(Yg + l * 264 + cgi * 8) = pack8(o); }
    }
    __syncthreads();
    const int t = 16 * wave + fr; const bf16_t* glut = (const bf16_t*)(ws + woff(W_GLU, layer));
    f32x4 acc[16];
#pragma unroll
    for (int j = 0; j < 16; ++j) acc[j] = (f32x4){0.f, 0.f, 0.f, 0.f};
#pragma unroll 1
    for (int ks = 0; ks < 8; ++ks) { const bf16x8 sec = *(const bf16x8*)(Yg + t * 264 + ks * 32 + fq * 8);
#pragma unroll
        for (int j = 0; j < 16; ++j) { const bf16x8 fst = *(const bf16x8*)(glut + (size_t)(16 * j + fr) * 256 + ks * 32 + fq * 8); acc[j] = MFMA32(fst, sec, acc[j]); } }
    float ss = 0.f; const float* gb = P.in(I_S5_GLUB) + layer * 256;
#pragma unroll
    for (int j = 0; j < 16; ++j) { const int n0 = 16 * j + 4 * fq; const u32x2 yw = *(const u32x2*)(Yg + t * 264 + n0); const f32x4 b4 = *(const f32x4*)(gb + n0);
        f32x4 o; o[0] = bflo(yw.x) * sigmoidf_(acc[j][0] + b4[0]); o[1] = bfhi(yw.x) * sigmoidf_(acc[j][1] + b4[1]); o[2] = bflo(yw.y) * sigmoidf_(acc[j][2] + b4[2]); o[3] = bfhi(yw.y) * sigmoidf_(acc[j][3] + b4[3]);
        acc[j] = o; ss += (o[0] * o[0] + o[1] * o[1]) + (o[2] * o[2] + o[3] * o[3]); }
    ss += __shfl_xor(ss, 16); ss += __shfl_xor(ss, 32);
    const float rstd = rsqrtf(ss * (1.0f / 256.0f) + 1e-6f); const float* onw = P.in(I_S5_ONORM) + layer * 256;
#pragma unroll
    for (int j = 0; j < 16; ++j) { const int n0 = 16 * j + 4 * fq; const f32x4 w4 = *(const f32x4*)(onw + n0); const f32x4 o = acc[j];
        u32x2 w; w.x = pk2(o[0] * rstd * w4[0], o[1] * rstd * w4[1]); w.y = pk2(o[2] * rstd * w4[2], o[3] * rstd * w4[3]); if (P.rep == 0) *(u32x2*)(mix + (size_t)(t0 + t) * 1024 + 512 + n0) = w; }
    __syncthreads();
}

__device__ __forceinline__ void convact_phase(const Ctx& P, int layer, int slab) {
    unsigned char* ws = P.ws(); const bf16_t* up = (const bf16_t*)(ws + R_UP); bf16_t* act = (bf16_t*)(ws + R_ACT);
    const float* cw = P.in(I_FFN_CW) + (size_t)layer * 3 * UPW; const float* cb = P.in(I_FFN_CB) + (size_t)layer * UPW;
    const int R0 = slab * SLAB; constexpr int NCG = DFF / 8, RB = 16;
    for (int it = blockIdx.x * 512 + ltid(); it < (SLAB / RB) * NCG; it += gridDim.x * 512) {
        const int rb = it / NCG, cgi = it % NCG, c0 = cgi * 8, r0 = rb * RB;
        float wg[3][8], wv[3][8], bg[8], bv[8];
#pragma unroll
        for (int k = 0; k < 3; ++k)
#pragma unroll
            for (int hlf = 0; hlf < 2; ++hlf) { const f32x4 a = *(const f32x4*)(cw + k * UPW + c0 + 4 * hlf), b = *(const f32x4*)(cw + k * UPW + DFF + c0 + 4 * hlf);
#pragma unroll
                for (int j = 0; j < 4; ++j) { wg[k][4 * hlf + j] = a[j]; wv[k][4 * hlf + j] = b[j]; } }
#pragma unroll
        for (int hlf = 0; hlf < 2; ++hlf) { const f32x4 a = *(const f32x4*)(cb + c0 + 4 * hlf), b = *(const f32x4*)(cb + DFF + c0 + 4 * hlf);
#pragma unroll
            for (int j = 0; j < 4; ++j) { bg[4 * hlf + j] = a[j]; bv[4 * hlf + j] = b[j]; } }
        const u32x4 zz = {0u, 0u, 0u, 0u};
        u32x4 pg = zz, pv = zz;
        if (!tok_first(R0 + r0)) { pg = *(const u32x4*)(up + (size_t)(r0 - 1) * UPW + c0); pv = *(const u32x4*)(up + (size_t)(r0 - 1) * UPW + DFF + c0); }
        u32x4 cg_ = *(const u32x4*)(up + (size_t)r0 * UPW + c0), cv = *(const u32x4*)(up + (size_t)r0 * UPW + DFF + c0);
#pragma unroll 2
        for (int i = 0; i < RB; ++i) { const int r = r0 + i; u32x4 ng = zz, nv = zz;
            if (!tok_last(R0 + r)) { ng = *(const u32x4*)(up + (size_t)(r + 1) * UPW + c0); nv = *(const u32x4*)(up + (size_t)(r + 1) * UPW + DFF + c0); }
            float a0[8], a1[8], a2[8], b0[8], b1[8], b2[8], o[8];
            unpack8(pg, a0); unpack8(cg_, a1); unpack8(ng, a2); unpack8(pv, b0); unpack8(cv, b1); unpack8(nv, b2);
#pragma unroll
            for (int j = 0; j < 8; ++j) { const float gt = bg[j] + wg[0][j] * a0[j] + wg[1][j] * a1[j] + wg[2][j] * a2[j]; const float vl = bv[j] + wv[0][j] * b0[j] + wv[1][j] * b1[j] + wv[2][j] * b2[j]; o[j] = siluf_(gt) * vl; }
            *(u32x4*)(act + (size_t)r * DFF + c0) = pack8(o);
            pg = cg_; pv = cv; cg_ = ng; cv = nv; }
    }
}

__device__ __forceinline__ void final_phase(const Ctx& P) {
    const int lane = ltid() & 63, wave = ltid() >> 6; const float* part = (const float*)(P.ws() + W_PARTA); const float* fw = P.in(I_FINAL_NORM); const bf16_t* xb = (const bf16_t*)(P.ws() + R_XALT);
    for (int row = blockIdx.x * 8 + wave; row < M_TOK; row += gridDim.x * 8) { const float rs = row_rstd16(part, row);
#pragma unroll
        for (int j = 0; j < 4; ++j) { const u32x2 xw = ((const u32x2*)(xb + (size_t)row * 1024))[lane + 64 * j]; const f32x4 w = ((const f32x4*)fw)[lane + 64 * j];
            f32x4 v; v[0] = bflo(xw.x) * rs * w[0]; v[1] = bfhi(xw.x) * rs * w[1]; v[2] = bflo(xw.y) * rs * w[2]; v[3] = bfhi(xw.y) * rs * w[3];
            ((f32x4*)(P.out() + (size_t)row * 1024))[lane + 64 * j] = v; } }
}

#ifndef PHMASK
#define PHMASK 0xFFFFFFFFu
#endif
#define PHM(n) (((PHMASK) >> (n)) & 1u)
__device__ __forceinline__ void run_phase(const Ctx& P, int ph, unsigned char* shm) {
    unsigned char* ws = P.ws();
    if (ph == 0) { prep_weights(P, 0, shm); xinit_phase(P); return; }
    if (ph == N_PHASES - 1) { final_phase(P); return; }
    const int layer = (ph - 1) / PH_PER_LAYER, sub = (ph - 1) % PH_PER_LAYER;
    bf16_t* xbf = (bf16_t*)(ws + R_XBF); bf16_t* xalt = (bf16_t*)P.out();
    float* partA = (float*)(ws + W_PARTA); float* partB = (float*)(ws + W_PARTB);
    if (sub == 0) { EpiProj E; E.proj = (bf16_t*)(ws + R_PROJ); E.dt = (float*)(ws + W_DT); E.part = partA; run_gemm(shm, xalt, (const bf16_t*)(ws + woff(W_WIN, layer)), M_TOK, INP, 1024, E); }
    else if (sub == 1) {
        for (int it = blockIdx.x; it < 1536; it += gridDim.x) {
            if (it < 768) ssd_s1_item(P, layer, it, shm);
            else if (it < 1152) sgu_item(P, layer, it - 768, shm);
            else s5_item<false>(P, layer, it - 1152, shm);
        }
    }
    else if (sub == 2) {
        for (int it = blockIdx.x; it < 576; it += gridDim.x) ssd_scan_item(P, it);
        s5_carry(P, layer);
        pconv_phase(P, layer);
        if (layer + 1 < NLAYER) prep_weights(P, layer + 1, shm);
    }
    else if (sub == 3) {
        for (int it = blockIdx.x; it < 1152; it += gridDim.x) { if (it < 768) ssd_s3_item(P, layer, it, shm); else { s5_item<true>(P, layer, it - 768, shm); __syncthreads(); } }
    }
    else if (sub == 4) { for (int it = blockIdx.x; it < NCHUNK; it += gridDim.x) finalize_item(P, layer, it, shm); }
    else if (sub == 5) { EpiResid<false> E; E.xin = xalt; E.xout = xbf; E.part_out = partA; E.part_in = nullptr; E.e = nullptr; E.rep = P.rep; run_gemm(shm, (const bf16_t*)(ws + R_MIX), (const bf16_t*)(ws + woff(W_WOUT, layer)), M_TOK, 1024, 1024, E); }
    else if (sub == 6) { EpiUpConv E; E.act = (bf16_t*)(ws + R_UP); E.edge = (bf16_t*)(ws + W_EDGE); E.part = partA; E.cw = P.in(I_FFN_CW) + (size_t)layer * 3 * UPW; E.cb = P.in(I_FFN_CB) + (size_t)layer * UPW; E.xbuf = (unsigned*)(shm + 131072);
        run_gemm(shm, xbf, (const bf16_t*)(ws + woff(W_WUP, layer)), M_TOK, UPW, 1024, E); }
    else if (sub == 7) {
        ffn_fixup_phase(P, layer);
        EpiBf16S<false> E; E.O = (bf16_t*)(ws + R_E); E.ldc = 1024; E.part = nullptr; run_gemm(shm, (const bf16_t*)(ws + W_PBF), (const bf16_t*)(ws + woff(W_WP, layer)), M_TOK, 1024, 256, E); }
    else if (sub == 8) { EpiResid<false> E; E.xin = xbf; E.xout = xbf; E.part_out = partB; E.part_in = nullptr; E.e = nullptr; E.rep = P.rep; run_gemm(shm, (const bf16_t*)(ws + R_UP), (const bf16_t*)(ws + woff(W_WDOWN, layer)), M_TOK, 1024, DFF, E); }
    else { EpiResid<true> E; E.xin = xbf; E.xout = (layer == NLAYER - 1) ? (bf16_t*)(ws + R_XALT) : xalt; E.part_out = partA; E.part_in = partB; E.e = (const bf16_t*)(ws + R_E); E.rep = P.rep; run_gemm(shm, xbf, (const bf16_t*)(ws + woff(W_WG, layer)), M_TOK, 1024, 1024, E); }
}

#define XB_TMO      128
#define XB_XCNT(j)  (256  + 64 * (j))
#define XB_XSUB(j)  (1280 + 64 * (j))
#define XB_XGEN(j)  (2304 + 64 * (j))
#define XB_TOP      3328
#define XB_TOPGEN   3392
#define XCD_BAR_WORDS 3456
#define XB_SPIN_CAP (1u << 18)
#define LAS __attribute__((address_space(3)))

__device__ __forceinline__ unsigned xb_ld(unsigned* p)              { return __hip_atomic_load(p, __ATOMIC_RELAXED, __HIP_MEMORY_SCOPE_AGENT); }
__device__ __forceinline__ unsigned xb_add(unsigned* p, unsigned v) { return __hip_atomic_fetch_add(p, v, __ATOMIC_RELAXED, __HIP_MEMORY_SCOPE_AGENT); }
__device__ __forceinline__ unsigned xb_xcc_id() { return (unsigned)__builtin_amdgcn_s_getreg((3 << 11) | 20) & 0xFu; }
#define XB_SPIN(cond, bar) do { unsigned _sp = 0; while (cond) { __builtin_amdgcn_s_sleep(1); \
    if ((++_sp & 255u) == 0u) { if (xb_ld(&(bar)[XB_TMO])) break; if (_sp > XB_SPIN_CAP) { atomicAdd(&(bar)[XB_TMO], 1u); break; } } } } while (0)

struct XcdBarrier {
    unsigned* bar; unsigned x;
    volatile LAS unsigned* st;
};

__device__ __forceinline__ XcdBarrier xcd_barrier_post(unsigned* bar, volatile LAS unsigned* st) {
    XcdBarrier b; b.bar = bar; b.x = xb_xcc_id(); b.st = st;
    if (threadIdx.x == 0) (void)xb_add(&bar[XB_XCNT(b.x)], 1u);
    return b;
}
__device__ __forceinline__ void xcd_barrier_complete(unsigned* bar, unsigned x, unsigned& nloc, unsigned& nx) {
    const unsigned G = gridDim.x * gridDim.y * gridDim.z;
    unsigned sum, cnt, mine, sp = 0u;
    for (;;) {
        sum = 0u; cnt = 0u; mine = 0u;
#pragma unroll
        for (unsigned j = 0; j < 16; ++j) { const unsigned c = xb_ld(&bar[XB_XCNT(j)]); sum += c; cnt += (c > 0u) ? 1u : 0u; mine = (j == x) ? c : mine; }
        if (sum == G) break;
        __builtin_amdgcn_s_sleep(1);
        if ((++sp & 255u) == 0u) { if (xb_ld(&bar[XB_TMO])) break; if (sp > XB_SPIN_CAP) { atomicAdd(&bar[XB_TMO], 1u); break; } }
    }
    nloc = mine > 0u ? mine : 1u; nx = cnt > 0u ? cnt : 1u;
}

__device__ __forceinline__ void xcd_barrier(const XcdBarrier& b) {
    asm volatile("s_waitcnt vmcnt(0)" ::: "memory");
    __syncthreads();
    if (threadIdx.x == 0) {
        unsigned* bar = b.bar;
        __builtin_amdgcn_s_waitcnt(0);
        unsigned nloc = b.st[0], nx = b.st[1];
        if (nloc == 0u) { xcd_barrier_complete(bar, b.x, nloc, nx); b.st[0] = nloc; b.st[1] = nx; }
        const unsigned old = xb_add(&bar[XB_XSUB(b.x)], 1u);
        const unsigned gen = old / nloc;
        if (old + 1u == (gen + 1u) * nloc) {
            __builtin_amdgcn_fence(__ATOMIC_RELEASE, "agent");
            asm volatile("s_waitcnt vmcnt(0)" ::: "memory");
            const unsigned og = xb_add(&bar[XB_TOP], 1u);
            const unsigned tg = og / nx;
            if (og + 1u == (tg + 1u) * nx) xb_add(&bar[XB_TOPGEN], 1u);
            else XB_SPIN(xb_ld(&bar[XB_TOPGEN]) == tg, bar);
            __builtin_amdgcn_fence(__ATOMIC_ACQUIRE, "agent");
            xb_add(&bar[XB_XGEN(b.x)], 1u);
            asm volatile("s_waitcnt vmcnt(0)" ::: "memory");
        } else {
            XB_SPIN(xb_ld(&bar[XB_XGEN(b.x)]) == gen, bar);
            __builtin_amdgcn_fence(__ATOMIC_ACQUIRE, "agent");
            asm volatile("s_waitcnt vmcnt(0)" ::: "memory");
        }
    }
    __syncthreads();
}

__global__ void __launch_bounds__(512, 2) mega_fwd(Params P) {
    extern __shared__ __attribute__((aligned(16))) unsigned char shm[];
    cg::grid_group grid = cg::this_grid();
    if (P.ph_lo < 0) grid.sync();
    volatile LAS unsigned* st = (volatile LAS unsigned*)(shm + LDS_BYTES - 16);
    if (threadIdx.x == 0) { st[0] = 0u; st[1] = 0u; }
    __syncthreads();
    const XcdBarrier xb = xcd_barrier_post((unsigned*)(P.ws + W_BAR), st);
    for (int ph = P.ph_lo; ph < P.ph_hi; ++ph) {
        Ctx C; C.ka = (kaptr_t)__builtin_amdgcn_kernarg_segment_ptr(); asm volatile("" : "+s"(C.ka));
        C.rep = 0; run_phase(C, ph, shm);
#ifdef PROBE_MASK
        { const int sub_ = (ph - 1) % PH_PER_LAYER; if (ph > 0 && ph < N_PHASES - 1 && (((PROBE_MASK) >> sub_) & 1u)) { __syncthreads(); C.rep = 1; asm volatile("" : "+s"(C.rep)); run_phase(C, ph, shm); } }
#endif
        if (ph + 1 < P.ph_hi) xcd_barrier(xb);
    }
}

extern "C" void kernel_launch(void* const* d_in, const int* in_sizes, int n_in, void* d_out, int out_size, void* d_ws, size_t ws_size, hipStream_t stream) {
    static int grid = 0;
    if (grid == 0) {
        if (n_in != 38 || out_size != M_TOK * 1024 || ws_size < WS_TOTAL) { fprintf(stderr, "kernel_launch: unexpected shapes n_in %d out %d ws %zu (need %zu)\n", n_in, out_size, ws_size, (size_t)WS_TOTAL); grid = -1; return; }
        int dev = 0, cus = 0, per_cu = 0;
        (void)hipGetDevice(&dev); (void)hipDeviceGetAttribute(&cus, hipDeviceAttributeMultiprocessorCount, dev);
        if (hipFuncSetAttribute((const void*)mega_fwd, hipFuncAttributeMaxDynamicSharedMemorySize, LDS_BYTES) != hipSuccess) { fprintf(stderr, "kernel_launch: hipFuncSetAttribute failed\n"); grid = -1; return; }
        if (hipOccupancyMaxActiveBlocksPerMultiprocessor(&per_cu, (const void*)mega_fwd, 512, LDS_BYTES) != hipSuccess || per_cu < 1) { fprintf(stderr, "kernel_launch: occupancy query says %d\n", per_cu); per_cu = 1; }
        (void)hipGetLastError();
        grid = cus * per_cu;
    }
    if (grid < 0) return;
    Params p{};
    for (int i = 0; i < 38; ++i) p.in[i] = (const float*)d_in[i];
    p.out = (float*)d_out; p.ws = (unsigned char*)d_ws;
#ifdef DBG_FILL
    (void)hipMemsetAsync(d_ws, 0, WS_TOTAL, stream);
#endif
    (void)hipMemsetAsync((unsigned char*)d_ws + W_BAR, 0, 16384, stream);
#if SINGLE_LAUNCH
    p.ph_lo = 0; p.ph_hi = N_PHASES;
    void* args[] = {&p};
    hipError_t e = hipLaunchCooperativeKernel((const void*)mega_fwd, dim3(grid), dim3(512), args, LDS_BYTES, stream);
    if (e != hipSuccess) fprintf(stderr, "cooperative launch failed: %s (grid %d)\n", hipGetErrorString(e), grid);
#else
    for (int ph = 0; ph < N_PHASES; ++ph) { p.ph_lo = ph; p.ph_hi = ph + 1; hipLaunchKernelGGL(mega_fwd, dim3(grid), dim3(512), LDS_BYTES, stream, p); }
#endif
}
```

```cpp
#include <hip/hip_runtime.h>
#include <hip/hip_cooperative_groups.h>
#include <cstdio>
#include <cstdint>
namespace cg = cooperative_groups;
#ifndef SINGLE_LAUNCH
#define SINGLE_LAUNCH 1
#endif
namespace pg8 {
#define PG8_LAS __attribute__((address_space(3)))
typedef unsigned short bf16_t;
typedef short bf16x8 __attribute__((ext_vector_type(8)));
typedef float f32x4 __attribute__((ext_vector_type(4)));
typedef unsigned u32x4 __attribute__((ext_vector_type(4)));
constexpr int BM = 256, BK = 64, HALF = 128, HTB = HALF * BK * 2  , STAGE_BYTES = 8 * HTB, NXCD = 8, WGM = 8;

__host__ __device__ __forceinline__ int lds_byte(int r, int c) { const int st = (r >> 4) * 2 + (c >> 5), rr = r & 15, cc = c & 31, ob = rr * 64 + cc * 2; return st * 1024 + (ob ^ (((ob >> 9) & 1) << 5)); }
__host__ __device__ __forceinline__ void stage_rc(int b, int& R, int& C) { const int st = b / 1024, sb = b % 1024, swz = sb ^ (((sb >> 9) & 1) << 5); R = (st >> 1) * 16 + swz / 64; C = (st & 1) * 32 + (swz % 64) / 2; }
__host__ __device__ __forceinline__ int perm32(int rho) { const int n = rho >> 4, i = rho & 15; return 8 * (i >> 2) + 4 * n + (i & 3); }

struct Unit { int pm, pn; };
struct Gemm { const bf16_t* A; const bf16_t* Bt; int M, N, K; };

struct StaticOrder {
    int nM, nN, nwg, G, c;
    __host__ __device__ void init(int M, int N, int G_, int c_) { nM = M / BM; nN = N / BM; nwg = nM * nN; G = G_; c = c_; }
    __host__ __device__ bool next(int i, Unit& u) const {
        const long L = (long)i * G + c; if (L >= nwg) return false;
        int wgid = (int)L; { const int q = nwg / NXCD, r = nwg % NXCD, xcd = wgid % NXCD, off = wgid / NXCD; wgid = (xcd < r ? xcd * (q + 1) : r * (q + 1) + (xcd - r) * q) + off; }
        const int nig = WGM * nN, gid = wgid / nig, fm = gid * WGM, gsz = (nM - fm) < WGM ? (nM - fm) : WGM;
        u.pm = fm + ((wgid % nig) % gsz); u.pn = (wgid % nig) / gsz; return true;
    }
    __device__ __forceinline__ void a_ready(const Unit&) const {}
    __device__ __forceinline__ void done(const Unit&) const {}
};

template <class Epi, class Sched, bool ALIGN_EPI = false, bool SP2 = false>
__device__ __forceinline__ void gemm_phase(PG8_LAS unsigned char* lds, const Gemm g, const Sched& S, const Epi& E) {
    int tid_ = threadIdx.x; asm volatile("" : "+v"(tid_)); const int tid = tid_, wid = __builtin_amdgcn_readfirstlane(tid >> 6), lane = tid & 63, wr = wid >> 2, wc = wid & 3, fr = lane & 15, fq = lane >> 4;
    const int K = g.K, nt = K / BK;
    unsigned voffA[2], voffB[2];
#pragma unroll
    for (int i = 0; i < 2; ++i) { int R, C; stage_rc(tid * 16 + i * 8192, R, C); const int Rb = Epi::PERM ? ((R & ~31) + perm32(R & 31)) : R;
        voffA[i] = (unsigned)(R * K + C) * 2u; voffB[i] = (unsigned)(Rb * K + C) * 2u; }
    const size_t kstep = (size_t)(BK * 2);
    const size_t hstep = (size_t)HALF * K * 2;
    const size_t tstep = 2 * hstep;
    const unsigned ldsw = (unsigned)wid * 1024u;
    const int aoff = lds_byte(wr * 64 + fr, fq * 8), boff = lds_byte(wc * 32 + fr, fq * 8);
#define PG8_SA(b, h) (((b) * 2 + (h)) * HTB)
#define PG8_SB(b, h) ((4 + (b) * 2 + (h)) * HTB)
#define PG8_STAGE(bufoff, gbase, voff) do { _Pragma("unroll") for (int _i = 0; _i < 2; ++_i) \
        __builtin_amdgcn_global_load_lds((const unsigned*)((const char*)(gbase) + (voff)[_i]), (PG8_LAS unsigned*)(lds + (bufoff) + ldsw + _i * 8192), 16, 0, 0); } while (0)
#define PG8_LDA(dst, b, h) do { _Pragma("unroll") for (int m = 0; m < 4; ++m) _Pragma("unroll") for (int k = 0; k < 2; ++k) dst[m][k] = *(const PG8_LAS bf16x8*)(lds + PG8_SA(b, h) + aoff + m * 2048 + k * 1024); } while (0)
#define PG8_LDB(dst, b, h) do { _Pragma("unroll") for (int n = 0; n < 2; ++n) _Pragma("unroll") for (int k = 0; k < 2; ++k) dst[n][k] = *(const PG8_LAS bf16x8*)(lds + PG8_SB(b, h) + boff + n * 2048 + k * 1024); } while (0)
#define PG8_MMA(ai, bj, At, Bt) do { __builtin_amdgcn_s_setprio(1); _Pragma("unroll") for (int m = 0; m < 4; ++m) _Pragma("unroll") for (int n = 0; n < 2; ++n) _Pragma("unroll") for (int k = 0; k < 2; ++k) \
        acc[ai][bj][m][n] = __builtin_amdgcn_mfma_f32_16x16x32_bf16(Bt[n][k], At[m][k], acc[ai][bj][m][n], 0, 0, 0); __builtin_amdgcn_s_setprio(0); } while (0)
#define PG8_WAIT_V(n) asm volatile("s_waitcnt vmcnt(" #n ")" ::: "memory")
#define PG8_WAIT_L(n) asm volatile("s_waitcnt lgkmcnt(" #n ")" ::: "memory")
#define PG8_BAR __builtin_amdgcn_s_barrier()
#define PG8_SCHED __builtin_amdgcn_sched_barrier(0)
    Unit cur, nxt; int ui = 0;
    if (!S.next(0, cur)) return;
    f32x4 acc[2][2][4][2];
#pragma unroll
    for (int a = 0; a < 2; ++a)
#pragma unroll
        for (int b = 0; b < 2; ++b)
#pragma unroll
            for (int m = 0; m < 4; ++m)
#pragma unroll
                for (int n = 0; n < 2; ++n) acc[a][b][m][n] = (f32x4){0.f, 0.f, 0.f, 0.f};
    bf16x8 At[4][2], B0[2][2], B1[2][2];
    const char* cA = (const char*)g.A + (size_t)cur.pm * tstep; const char* cB = (const char*)g.Bt + (size_t)cur.pn * tstep;
    S.a_ready(cur);
    if constexpr (SP2) {
        PG8_STAGE(PG8_SB(0, 0), cB, voffB); PG8_STAGE(PG8_SB(0, 1), cB + hstep, voffB); PG8_STAGE(PG8_SA(0, 0), cA, voffA); PG8_STAGE(PG8_SA(0, 1), cA + hstep, voffA);
        if (wr == 1) PG8_BAR;
        PG8_WAIT_V(2); PG8_BAR;
        PG8_STAGE(PG8_SB(1, 0), cB + kstep, voffB); PG8_STAGE(PG8_SA(1, 0), cA + kstep, voffA); PG8_STAGE(PG8_SB(1, 1), cB + hstep + kstep, voffB);
        PG8_WAIT_V(6); PG8_BAR;
    } else {
        PG8_STAGE(PG8_SB(0, 0), cB, voffB); PG8_STAGE(PG8_SA(0, 0), cA, voffA); PG8_STAGE(PG8_SB(0, 1), cB + hstep, voffB); PG8_STAGE(PG8_SA(0, 1), cA + hstep, voffA);
        if (wr == 1) PG8_BAR;
        PG8_WAIT_V(4); PG8_BAR;
        PG8_STAGE(PG8_SB(1, 0), cB + kstep, voffB); PG8_STAGE(PG8_SA(1, 0), cA + kstep, voffA); PG8_STAGE(PG8_SB(1, 1), cB + hstep + kstep, voffB);
        PG8_WAIT_V(6); PG8_BAR;
    }
    for (;;) {
        const bool has_next = S.next(ui + 1, nxt);
        const char* nA = has_next ? (const char*)g.A + (size_t)nxt.pm * tstep : cA; const char* nB = has_next ? (const char*)g.Bt + (size_t)nxt.pn * tstep : cB;
        for (int t = 0; t < nt; t += 2) {
            const bool last = (t == nt - 2);
            const char* a1 = cA + (size_t)(t + 1) * kstep;
            const char* a2 = last ? nA : cA + (size_t)(t + 2) * kstep; const char* b2 = last ? nB : cB + (size_t)(t + 2) * kstep;
            const char* a3 = a2 + kstep; const char* b3 = b2 + kstep;
            if (last && has_next) S.a_ready(nxt);
            if constexpr (SP2) {
            PG8_LDB(B0, 0, 0); PG8_LDB(B1, 0, 1); PG8_SCHED; PG8_LDA(At, 0, 0); PG8_STAGE(PG8_SA(1, 1), a1 + hstep, voffA);
            PG8_WAIT_V(8); PG8_WAIT_L(0); PG8_BAR; PG8_MMA(0, 0, At, B0); PG8_MMA(0, 1, At, B1); PG8_BAR; PG8_SCHED;
            PG8_LDA(At, 0, 1); PG8_STAGE(PG8_SB(0, 0), b2, voffB); PG8_STAGE(PG8_SB(0, 1), b2 + hstep, voffB); PG8_STAGE(PG8_SA(0, 0), a2, voffA);
            PG8_WAIT_V(8); PG8_WAIT_L(0); PG8_BAR; PG8_MMA(1, 0, At, B0); PG8_MMA(1, 1, At, B1); PG8_BAR; PG8_SCHED;
            PG8_LDB(B0, 1, 0); PG8_LDB(B1, 1, 1); PG8_SCHED; PG8_LDA(At, 1, 0); PG8_STAGE(PG8_SA(0, 1), a2 + hstep, voffA);
            PG8_WAIT_V(8); PG8_WAIT_L(0); PG8_BAR; PG8_MMA(0, 0, At, B0); PG8_MMA(0, 1, At, B1); PG8_BAR; PG8_SCHED;
            PG8_LDA(At, 1, 1); PG8_STAGE(PG8_SB(1, 0), b3, voffB); PG8_STAGE(PG8_SB(1, 1), b3 + hstep, voffB); PG8_STAGE(PG8_SA(1, 0), a3, voffA);
            PG8_WAIT_V(8); PG8_WAIT_L(0); PG8_BAR; PG8_MMA(1, 0, At, B0); PG8_MMA(1, 1, At, B1); PG8_BAR; PG8_SCHED;
            } else {
            PG8_LDB(B0, 0, 0); PG8_SCHED; PG8_LDA(At, 0, 0); PG8_STAGE(PG8_SA(1, 1), a1 + hstep, voffA);
            PG8_WAIT_L(8); PG8_BAR; PG8_WAIT_L(0); PG8_MMA(0, 0, At, B0); PG8_BAR; PG8_SCHED;
            PG8_LDB(B1, 0, 1); PG8_STAGE(PG8_SB(0, 0), b2, voffB);
            PG8_BAR; PG8_WAIT_L(0); PG8_MMA(0, 1, At, B1); PG8_BAR;
            PG8_LDA(At, 0, 1); PG8_STAGE(PG8_SA(0, 0), a2, voffA);
            PG8_BAR; PG8_WAIT_L(0); PG8_MMA(1, 0, At, B0); PG8_BAR; PG8_SCHED;
            PG8_STAGE(PG8_SB(0, 1), b2 + hstep, voffB);
            PG8_WAIT_V(6); PG8_BAR; PG8_MMA(1, 1, At, B1); PG8_BAR;
            PG8_LDB(B0, 1, 0); PG8_SCHED; PG8_LDA(At, 1, 0); PG8_STAGE(PG8_SA(0, 1), a2 + hstep, voffA);
            PG8_WAIT_L(8); PG8_BAR; PG8_WAIT_L(0); PG8_MMA(0, 0, At, B0); PG8_BAR; PG8_SCHED;
            PG8_LDB(B1, 1, 1); PG8_STAGE(PG8_SB(1, 0), b3, voffB);
            PG8_BAR; PG8_WAIT_L(0); PG8_MMA(0, 1, At, B1); PG8_BAR;
            PG8_LDA(At, 1, 1); PG8_STAGE(PG8_SA(1, 0), a3, voffA);
            PG8_BAR; PG8_WAIT_L(0); PG8_MMA(1, 0, At, B0); PG8_BAR; PG8_SCHED;
            PG8_STAGE(PG8_SB(1, 1), b3 + hstep, voffB);
            PG8_WAIT_V(6); PG8_BAR; PG8_MMA(1, 1, At, B1); PG8_BAR;
            }
        }
        if constexpr (ALIGN_EPI) { if (wr == 0) PG8_BAR; }
        if constexpr (!Epi::AFTER_DRAIN) { E(acc, cur, wr, wc, fr, fq); S.done(cur); }
        if (!has_next) break;
#pragma unroll
        for (int a = 0; a < 2; ++a)
#pragma unroll
            for (int b = 0; b < 2; ++b)
#pragma unroll
                for (int m = 0; m < 4; ++m)
#pragma unroll
                    for (int n = 0; n < 2; ++n) acc[a][b][m][n] = (f32x4){0.f, 0.f, 0.f, 0.f};
        cur = nxt; cA = nA; cB = nB; ++ui;
        if constexpr (ALIGN_EPI) { if (wr == 1) PG8_BAR; }
    }
    PG8_WAIT_V(0);
    if constexpr (!ALIGN_EPI) { if (wr == 0) PG8_BAR; }
    PG8_BAR;
    if constexpr (Epi::AFTER_DRAIN) { E.fused(acc, cur, wr, wc, fr, fq, lds, wid, lane); S.done(cur); }
#undef PG8_SA
#undef PG8_SB
#undef PG8_STAGE
#undef PG8_LDA
#undef PG8_LDB
#undef PG8_MMA
#undef PG8_WAIT_V
#undef PG8_WAIT_L
#undef PG8_BAR
#undef PG8_SCHED
}
}
using pg8::bf16_t; using pg8::bf16x8; using pg8::f32x4; using pg8::u32x4; using pg8::Unit;
typedef short bf16x4 __attribute__((ext_vector_type(4)));
typedef unsigned u32x2 __attribute__((ext_vector_type(2)));
typedef float f32x2v __attribute__((ext_vector_type(2)));

constexpr int M_TOK = 49152, MP = 32768, DM = 1024, INW = 2320, INP = 2560, DFF = 2816, UPW = 5632, PLE = 256;
constexpr int O_XBC = 512, O_DT = 1536, O_S5 = 1552, O_SGU = 1808;
constexpr int NCHUNK = 384, SLAB = 16384, NSLAB = 3, NLAYER = 4;
constexpr int LDS_BYTES = 147456;
constexpr int PH_PER_LAYER = 10, N_PHASES = NLAYER * PH_PER_LAYER + 2;

constexpr size_t SZ_XBF = (size_t)M_TOK * 1024 * 2;
constexpr size_t SZ_PROJ = (size_t)M_TOK * INW * 2;
constexpr size_t SZ_STATES = (size_t)NCHUNK * 2 * 8 * 8192 * 2;
constexpr size_t SZ_S5Y = (size_t)2 * M_TOK * 256 * 2;
constexpr size_t SZ_UP = (size_t)SLAB * UPW * 2;
constexpr size_t SZ_ACT = (size_t)SLAB * DFF * 2;
constexpr size_t R_PROJ = 0, R_STATES = SZ_PROJ, R_MIX = R_STATES + SZ_STATES, R_S5Y = R_MIX + SZ_XBF, R_END = R_S5Y + SZ_S5Y;
constexpr size_t R_XBF = 0, R_UP = SZ_XBF, R_ACT = R_UP + SZ_UP, R_XALT = R_ACT + SZ_ACT, R_E = R_XALT;
static_assert(R_XALT + SZ_XBF <= R_END, "xalt must fit");
static_assert(R_XALT >= SZ_PROJ, "xalt must not overlap proj");
constexpr size_t W_WIN = R_END;
constexpr size_t W_WOUT = W_WIN + (size_t)INP * 1024 * 2;
constexpr size_t W_WUP = W_WOUT + (size_t)1024 * 1024 * 2;
constexpr size_t W_WDOWN = W_WUP + (size_t)UPW * 1024 * 2;
constexpr size_t W_WP = W_WDOWN + (size_t)1024 * DFF * 2;
constexpr size_t W_WG = W_WP + (size_t)1024 * 256 * 2;
constexpr size_t W_GLU = W_WG + (size_t)1024 * 1024 * 2;
constexpr size_t W_SGU = W_GLU + (size_t)256 * 256 * 2;
constexpr size_t W_PBF = W_SGU + (size_t)4 * 128 * 128 * 2;
constexpr size_t W_DT = W_PBF + (size_t)M_TOK * 256 * 2;
constexpr size_t W_PARTA = W_DT + (size_t)M_TOK * 16 * 4;
constexpr size_t W_PARTB = W_PARTA + (size_t)M_TOK * 16 * 4;
constexpr size_t W_SSQ = W_PARTB + (size_t)M_TOK * 16 * 4;
constexpr size_t W_DECAY = W_SSQ + (size_t)M_TOK * 2 * 4;
constexpr size_t W_HLOC = W_DECAY + (size_t)NCHUNK * 16 * 4;
constexpr size_t W_HIN = W_HLOC + (size_t)NCHUNK * 2 * 16 * 64 * 8;
constexpr size_t W_AB = W_HIN + (size_t)NCHUNK * 2 * 16 * 64 * 8;
constexpr size_t W_ABL = W_AB + (size_t)2 * 16 * 64 * 8;
constexpr size_t W_BOP = W_ABL + (size_t)2 * 16 * 64 * 8;
constexpr size_t W_COP = W_BOP + (size_t)2 * 16 * 128 * 16 * 2;
constexpr size_t W_EDGE = W_COP + (size_t)16 * 16 * 128 * 2;
constexpr size_t W_BAR = W_EDGE + (size_t)(M_TOK / 256) * 4 * 2 * DFF * 2;
constexpr size_t W2_BASE = W_BAR + 16384;
constexpr size_t WS_TOTAL = W2_BASE + (W_PBF - W_WIN) + (W_EDGE - W_AB);
__host__ __device__ __forceinline__ size_t woff(size_t off, int layer) { return !(layer & 1) ? off : (off < W_PBF ? W2_BASE + (off - W_WIN) : W2_BASE + (W_PBF - W_WIN) + (off - W_AB)); }

struct Params {
    const float* in[38];
    float* out; unsigned char* ws;
    int ph_lo, ph_hi;
};
typedef const __attribute__((address_space(4))) unsigned char* kaptr_t;
struct Ctx {
    kaptr_t ka; int rep;
    __device__ __forceinline__ const float* in(int i) const { return *(const float* const __attribute__((address_space(4)))*)(ka + 8 * i); }
    __device__ __forceinline__ float* out() const { return *(float* const __attribute__((address_space(4)))*)(ka + 8 * 38); }
    __device__ __forceinline__ unsigned char* ws() const { return *(unsigned char* const __attribute__((address_space(4)))*)(ka + 8 * 39); }
};
enum { I_XP = 0, I_XS, I_PP, I_PS, I_NORM_MIX, I_W_IN, I_SSD_CW, I_SSD_CB, I_SSD_DTB, I_SSD_ALOG, I_SSD_D, I_SSD_NORM, I_S5_LRE, I_S5_LIM, I_S5_LSTEP,
       I_S5_BRE, I_S5_BIM, I_S5_CRE, I_S5_CIM, I_S5_D, I_S5_GLUW, I_S5_GLUB, I_S5_ONORM, I_SGU_NW, I_SGU_NB, I_SGU_W, I_SGU_B, I_SGU_ONORM, I_W_OUT, I_NORM_FFN,
       I_FFN_UP, I_FFN_CW, I_FFN_CB, I_FFN_DOWN, I_PLE_PROJ, I_PLE_NORM, I_PLE_GATE, I_FINAL_NORM };

__device__ __forceinline__ int ltid() { int t = threadIdx.x; asm volatile("" : "+v"(t)); return t; }
__device__ __forceinline__ float bflo(unsigned w) { return __uint_as_float(w << 16); }
__device__ __forceinline__ float bfhi(unsigned w) { return __uint_as_float(w & 0xffff0000u); }
__device__ __forceinline__ float bf2f(bf16_t b) { return __uint_as_float(((unsigned)b) << 16); }
typedef __bf16 nbf16x2 __attribute__((ext_vector_type(2)));
__device__ __forceinline__ unsigned pk2(float lo, float hi) { f32x2v v; v.x = lo; v.y = hi; const nbf16x2 b = __builtin_convertvector(v, nbf16x2); return __builtin_bit_cast(unsigned, b); }
__device__ __forceinline__ bf16_t f2bf(float f) { return (bf16_t)(pk2(f, 0.f) & 0xffffu); }
__device__ __forceinline__ void unpack8(const u32x4 r, float (&v)[8]) { v[0] = bflo(r.x); v[1] = bfhi(r.x); v[2] = bflo(r.y); v[3] = bfhi(r.y); v[4] = bflo(r.z); v[5] = bfhi(r.z); v[6] = bflo(r.w); v[7] = bfhi(r.w); }
__device__ __forceinline__ u32x4 pack8(const float (&v)[8]) { u32x4 o; o.x = pk2(v[0], v[1]); o.y = pk2(v[2], v[3]); o.z = pk2(v[4], v[5]); o.w = pk2(v[6], v[7]); return o; }
__device__ __forceinline__ float sigmoidf_(float x) { return __builtin_amdgcn_rcpf(1.0f + __builtin_amdgcn_exp2f(x * -1.4426950408889634f)); }
__device__ __forceinline__ float siluf_(float x) { return x * sigmoidf_(x); }
__device__ __forceinline__ float geluf_(float x) { const float u = 0.7978845608f * (x + 0.044715f * x * x * x); return x * sigmoidf_(2.0f * u); }
__device__ __forceinline__ float softplusf_(float x) { return x > 20.f ? x : __logf(1.0f + __expf(x)); }
__device__ __forceinline__ bool tok_first(int t) { return t < MP ? ((t & 2047) == 0) : (((t - MP) & 8191) == 0); }
__device__ __forceinline__ bool tok_last(int t) { return t < MP ? ((t & 2047) == 2047) : (((t - MP) & 8191) == 8191); }
__device__ __forceinline__ float wave_incl_scan(float v, int lane) {
#pragma unroll
    for (int o = 1; o < 64; o <<= 1) { const float t = __shfl_up(v, o); if (lane >= o) v += t; }
    return v;
}
__device__ __forceinline__ float row_rstd16(const float* part, int row) {
    const f32x4* p = (const f32x4*)(part + (size_t)row * 16);
    const f32x4 a = p[0], b = p[1], c = p[2], d = p[3];
    const float s = (((a[0] + a[1]) + (a[2] + a[3])) + ((b[0] + b[1]) + (b[2] + b[3]))) + (((c[0] + c[1]) + (c[2] + c[3])) + ((d[0] + d[1]) + (d[2] + d[3])));
    return rsqrtf(s * (1.0f / 1024.0f) + 1e-6f);
}
struct RowRs { float s0, s1; };
__device__ __forceinline__ RowRs rowrs_load(const float* part, int rowbase  , int lane) {
    RowRs r; const int rr = rowbase + (lane >> 4) * 16 + (lane & 15); r.s0 = row_rstd16(part, rr); r.s1 = row_rstd16(part, rr + 128); return r;
}
__device__ __forceinline__ float rowrs_get(const RowRs& r, int ai, int m, int fr) { return __shfl(ai ? r.s1 : r.s0, m * 16 + fr); }
__device__ __forceinline__ int prow(int j, int i) { return 32 * (j >> 1) + 8 * (i >> 2) + 4 * (j & 1) + (i & 3); }
#define MFMA32(a, b, c) __builtin_amdgcn_mfma_f32_16x16x32_bf16((a), (b), (c), 0, 0, 0)
#define MFMA16(a, b, c) __builtin_amdgcn_mfma_f32_16x16x16bf16_1k((a), (b), (c), 0, 0, 0)
#define WAVE_LDS_FENCE() do { asm volatile("s_waitcnt lgkmcnt(0)" ::: "memory"); __builtin_amdgcn_wave_barrier(); } while (0)

#ifndef GEMM_ALIGN_EPI
#define GEMM_ALIGN_EPI true
#endif
#ifndef GEMM_SP2
#define GEMM_SP2 true
#endif
struct EpiProj {
    static constexpr bool PERM = true, AFTER_DRAIN = false;
    bf16_t* proj; float* dt; const float* part;
    __device__ __forceinline__ void operator()(const f32x4 (&acc)[2][2][4][2], const Unit& u, int wr, int wc, int fr, int fq) const {
        const int row0 = u.pm * 256 + wr * 64 + fr, colb = u.pn * 256 + wc * 32 + 8 * fq;
        const RowRs rr = rowrs_load(part, u.pm * 256 + wr * 64, fq * 16 + fr);
#pragma unroll
        for (int ai = 0; ai < 2; ++ai)
#pragma unroll
            for (int m = 0; m < 4; ++m) {
                const int row = row0 + ai * 128 + m * 16; const float rs = rowrs_get(rr, ai, m, fr);
#pragma unroll
                for (int bj = 0; bj < 2; ++bj) {
                    const int col = colb + bj * 128; const f32x4 v0 = acc[ai][bj][m][0] * rs, v1 = acc[ai][bj][m][1] * rs;
                    if (col < INW) { u32x4 w; w.x = pk2(v0[0], v0[1]); w.y = pk2(v0[2], v0[3]); w.z = pk2(v1[0], v1[1]); w.w = pk2(v1[2], v1[3]); *(u32x4*)(proj + (size_t)row * INW + col) = w; }
                    if (col >= O_DT && col < O_DT + 16) { float* d = dt + (size_t)row * 16 + (col - O_DT); *(f32x4*)d = v0; *(f32x4*)(d + 4) = v1; }
                }
            }
    }
};
template <bool SCALE> struct EpiBf16S {
    static constexpr bool PERM = true, AFTER_DRAIN = false;
    bf16_t* O; int ldc; const float* part;
    __device__ __forceinline__ void operator()(const f32x4 (&acc)[2][2][4][2], const Unit& u, int wr, int wc, int fr, int fq) const {
        const int row0 = u.pm * 256 + wr * 64 + fr, colb = u.pn * 256 + wc * 32 + 8 * fq;
        RowRs rr; rr.s0 = 1.f; rr.s1 = 1.f; if (SCALE) rr = rowrs_load(part, u.pm * 256 + wr * 64, fq * 16 + fr);
#pragma unroll
        for (int ai = 0; ai < 2; ++ai)
#pragma unroll
            for (int m = 0; m < 4; ++m) {
                const int row = row0 + ai * 128 + m * 16; float rs = 1.0f; if (SCALE) rs = rowrs_get(rr, ai, m, fr);
#pragma unroll
                for (int bj = 0; bj < 2; ++bj) {
                    const int col = colb + bj * 128; const f32x4 v0 = acc[ai][bj][m][0] * rs, v1 = acc[ai][bj][m][1] * rs;
                    u32x4 w; w.x = pk2(v0[0], v0[1]); w.y = pk2(v0[2], v0[3]); w.z = pk2(v1[0], v1[1]); w.w = pk2(v1[2], v1[3]); *(u32x4*)(O + (size_t)row * ldc + col) = w;
                }
            }
    }
};
template <bool GATE> struct EpiResid {
    static constexpr bool PERM = true, AFTER_DRAIN = false;
    const bf16_t* xin; bf16_t* xout; float* part_out; const float* part_in; const bf16_t* e; int rep;
    __device__ __forceinline__ void operator()(const f32x4 (&acc)[2][2][4][2], const Unit& u, int wr, int wc, int fr, int fq) const {
        const int row0 = u.pm * 256 + wr * 64 + fr, colb = u.pn * 256 + wc * 32 + 8 * fq;
        RowRs rr; rr.s0 = 1.f; rr.s1 = 1.f; if (GATE) rr = rowrs_load(part_in, u.pm * 256 + wr * 64, fq * 16 + fr);
#pragma unroll
        for (int ai = 0; ai < 2; ++ai)
#pragma unroll
            for (int m = 0; m < 4; ++m) {
                const int row = row0 + ai * 128 + m * 16; float rs = 1.0f; if (GATE) rs = rowrs_get(rr, ai, m, fr);
                float ss = 0.f;
#pragma unroll
                for (int bj = 0; bj < 2; ++bj) {
                    const size_t o = (size_t)row * 1024 + colb + bj * 128;
                    float v[8]; unpack8(*(const u32x4*)(xin + o), v);
                    const f32x4 a0 = acc[ai][bj][m][0], a1 = acc[ai][bj][m][1];
                    if (GATE) { float ev[8]; unpack8(*(const u32x4*)(e + o), ev);
#pragma unroll
                        for (int j = 0; j < 4; ++j) { v[j] += sigmoidf_(a0[j] * rs) * ev[j]; v[4 + j] += sigmoidf_(a1[j] * rs) * ev[4 + j]; } }
                    else {
#pragma unroll
                        for (int j = 0; j < 4; ++j) { v[j] += a0[j]; v[4 + j] += a1[j]; } }
                    if (rep == 0) *(u32x4*)(xout + o) = pack8(v);
#pragma unroll
                    for (int j = 0; j < 8; ++j) ss += v[j] * v[j];
                }
                ss += __shfl_xor(ss, 16); ss += __shfl_xor(ss, 32);
                if (fq == 0 && rep == 0) part_out[(size_t)row * 16 + u.pn * 4 + wc] = ss;
                if (m == 1 || m == 3) asm volatile("" ::: "memory");
            }
    }
};
struct EpiUpConv {
    static constexpr bool PERM = true, AFTER_DRAIN = false;
    bf16_t* act; bf16_t* edge; const float* part; const float* cw; const float* cb; unsigned* xbuf;
    __device__ __forceinline__ void operator()(const f32x4 (&acc)[2][2][4][2], const Unit& u, int wr, int wc, int fr, int fq) const {
        const int lane = fq * 16 + fr; const int ch0 = u.pn * 128 + wc * 32 + 8 * fq;
        const RowRs rr = rowrs_load(part, u.pm * 256 + wr * 64, lane);
        unsigned G[2][4][4], V[2][4][4];
#pragma unroll
        for (int ai = 0; ai < 2; ++ai)
#pragma unroll
            for (int m = 0; m < 4; ++m) { const float rs = rowrs_get(rr, ai, m, fr);
                const f32x4 g0 = acc[ai][0][m][0] * rs, g1 = acc[ai][0][m][1] * rs, v0 = acc[ai][1][m][0] * rs, v1 = acc[ai][1][m][1] * rs;
                G[ai][m][0] = pk2(g0[0], g0[1]); G[ai][m][1] = pk2(g0[2], g0[3]); G[ai][m][2] = pk2(g1[0], g1[1]); G[ai][m][3] = pk2(g1[2], g1[3]);
                V[ai][m][0] = pk2(v0[0], v0[1]); V[ai][m][1] = pk2(v0[2], v0[3]); V[ai][m][2] = pk2(v1[0], v1[1]); V[ai][m][3] = pk2(v1[2], v1[3]); }
#pragma unroll
        for (int ai = 0; ai < 2; ++ai) { const int g4 = 2 * ai + wr;
            if (fr == 0) { unsigned* d = xbuf + ((((g4 * 2 + 0) * 4 + wc) * 4 + fq) * 8); *(u32x4*)d = (u32x4){G[ai][0][0], G[ai][0][1], G[ai][0][2], G[ai][0][3]}; *(u32x4*)(d + 4) = (u32x4){V[ai][0][0], V[ai][0][1], V[ai][0][2], V[ai][0][3]}; }
            if (fr == 15) { unsigned* d = xbuf + ((((g4 * 2 + 1) * 4 + wc) * 4 + fq) * 8); *(u32x4*)d = (u32x4){G[ai][3][0], G[ai][3][1], G[ai][3][2], G[ai][3][3]}; *(u32x4*)(d + 4) = (u32x4){V[ai][3][0], V[ai][3][1], V[ai][3][2], V[ai][3][3]}; } }
        if (wr == 0 && fr < 2) { bf16_t* d = edge + ((size_t)(u.pm * 4 + fr) * 2) * DFF + ch0; *(u32x4*)d = (u32x4){G[0][0][0], G[0][0][1], G[0][0][2], G[0][0][3]}; *(u32x4*)(d + DFF) = (u32x4){V[0][0][0], V[0][0][1], V[0][0][2], V[0][0][3]}; }
        if (wr == 1 && fr >= 14) { bf16_t* d = edge + ((size_t)(u.pm * 4 + 2 + (fr - 14)) * 2) * DFF + ch0; *(u32x4*)d = (u32x4){G[1][3][0], G[1][3][1], G[1][3][2], G[1][3][3]}; *(u32x4*)(d + DFF) = (u32x4){V[1][3][0], V[1][3][1], V[1][3][2], V[1][3][3]}; }
        asm volatile("s_waitcnt lgkmcnt(0)" ::: "memory"); __builtin_amdgcn_s_barrier(); asm volatile("" ::: "memory");
        if (!GEMM_ALIGN_EPI) { __builtin_amdgcn_s_barrier(); asm volatile("" ::: "memory"); }
        float wg[3][8], wv[3][8], bg[8], bv[8];
#pragma unroll
        for (int k = 0; k < 3; ++k)
#pragma unroll
            for (int hlf = 0; hlf < 2; ++hlf) { const f32x4 a = *(const f32x4*)(cw + k * UPW + ch0 + 4 * hlf), b = *(const f32x4*)(cw + k * UPW + DFF + ch0 + 4 * hlf);
#pragma unroll
                for (int j = 0; j < 4; ++j) { wg[k][4 * hlf + j] = a[j]; wv[k][4 * hlf + j] = b[j]; } }
#pragma unroll
        for (int hlf = 0; hlf < 2; ++hlf) { const f32x4 a = *(const f32x4*)(cb + ch0 + 4 * hlf), b = *(const f32x4*)(cb + DFF + ch0 + 4 * hlf);
#pragma unroll
            for (int j = 0; j < 4; ++j) { bg[4 * hlf + j] = a[j]; bv[4 * hlf + j] = b[j]; } }
        const int row0 = u.pm * 256 + wr * 64 + fr;
#pragma unroll
        for (int ai = 0; ai < 2; ++ai) { const int g4 = 2 * ai + wr;
            u32x4 xpg = {0u, 0u, 0u, 0u}, xpv = xpg, xng = xpg, xnv = xpg;
            if (g4 > 0) { const unsigned* d = xbuf + (((((g4 - 1) * 2 + 1) * 4 + wc) * 4 + fq) * 8); xpg = *(const u32x4*)d; xpv = *(const u32x4*)(d + 4); }
            if (g4 < 3) { const unsigned* d = xbuf + (((((g4 + 1) * 2 + 0) * 4 + wc) * 4 + fq) * 8); xng = *(const u32x4*)d; xnv = *(const u32x4*)(d + 4); }
#pragma unroll
            for (int m = 0; m < 4; ++m) {
                unsigned pg[4], pv[4], ng[4], nv[4];
#pragma unroll
                for (int e = 0; e < 4; ++e) {
                    const unsigned sg = (m > 0 && fr == 15) ? G[ai][m > 0 ? m - 1 : 0][e] : G[ai][m][e], sv = (m > 0 && fr == 15) ? V[ai][m > 0 ? m - 1 : 0][e] : V[ai][m][e];
                    const unsigned tg = (m < 3 && fr == 0) ? G[ai][m < 3 ? m + 1 : 3][e] : G[ai][m][e], tv = (m < 3 && fr == 0) ? V[ai][m < 3 ? m + 1 : 3][e] : V[ai][m][e];
                    pg[e] = (unsigned)__builtin_amdgcn_mov_dpp((int)sg, 0x121, 0xf, 0xf, false); pv[e] = (unsigned)__builtin_amdgcn_mov_dpp((int)sv, 0x121, 0xf, 0xf, false);
                    ng[e] = (unsigned)__builtin_amdgcn_mov_dpp((int)tg, 0x12F, 0xf, 0xf, false); nv[e] = (unsigned)__builtin_amdgcn_mov_dpp((int)tv, 0x12F, 0xf, 0xf, false);
                    if (m == 0) { pg[e] = fr == 0 ? xpg[e] : pg[e]; pv[e] = fr == 0 ? xpv[e] : pv[e]; }
                    if (m == 3) { ng[e] = fr == 15 ? xng[e] : ng[e]; nv[e] = fr == 15 ? xnv[e] : nv[e]; }
                }
                float o[8];
#pragma unroll
                for (int e = 0; e < 4; ++e) {
                    const float g_lo = bg[2 * e] + wg[0][2 * e] * bflo(pg[e]) + wg[1][2 * e] * bflo(G[ai][m][e]) + wg[2][2 * e] * bflo(ng[e]);
                    const float g_hi = bg[2 * e + 1] + wg[0][2 * e + 1] * bfhi(pg[e]) + wg[1][2 * e + 1] * bfhi(G[ai][m][e]) + wg[2][2 * e + 1] * bfhi(ng[e]);
                    const float v_lo = bv[2 * e] + wv[0][2 * e] * bflo(pv[e]) + wv[1][2 * e] * bflo(V[ai][m][e]) + wv[2][2 * e] * bflo(nv[e]);
                    const float v_hi = bv[2 * e + 1] + wv[0][2 * e + 1] * bfhi(pv[e]) + wv[1][2 * e + 1] * bfhi(V[ai][m][e]) + wv[2][2 * e + 1] * bfhi(nv[e]);
                    o[2 * e] = siluf_(g_lo) * v_lo; o[2 * e + 1] = siluf_(g_hi) * v_hi; }
                *(u32x4*)(act + (size_t)(row0 + ai * 128 + m * 16) * DFF + ch0) = pack8(o);
            }
        }
    }
};
__device__ __forceinline__ void ffn_fixup_phase(const Ctx& P, int layer) {
    unsigned char* ws = P.ws(); const bf16_t* edge = (const bf16_t*)(ws + W_EDGE); bf16_t* act = (bf16_t*)(ws + R_UP);
    const float* cw = P.in(I_FFN_CW) + (size_t)layer * 3 * UPW; const float* cb = P.in(I_FFN_CB) + (size_t)layer * UPW;
    constexpr int NCG = DFF / 8, NT = M_TOK / 256;
    for (int it = blockIdx.x * 512 + ltid(); it < NT * 2 * NCG; it += gridDim.x * 512) {
        const int cgi = it % NCG, t2 = it / NCG, pm = t2 >> 1, which = t2 & 1, c0 = cgi * 8, row = pm * 256 + (which ? 255 : 0);
        const u32x4 zz = {0u, 0u, 0u, 0u}; u32x4 pg = zz, pv = zz, ng = zz, nv = zz;
        const bf16_t* e0 = edge + (size_t)(pm * 4) * 2 * DFF + c0;
        const int jc = which ? 3 : 0;
        const u32x4 cg_ = *(const u32x4*)(e0 + (size_t)jc * 2 * DFF), cv = *(const u32x4*)(e0 + (size_t)jc * 2 * DFF + DFF);
        if (which) { pg = *(const u32x4*)(e0 + (size_t)2 * 2 * DFF); pv = *(const u32x4*)(e0 + (size_t)2 * 2 * DFF + DFF);
            if (!tok_last(row)) { ng = *(const u32x4*)(e0 + (size_t)4 * 2 * DFF); nv = *(const u32x4*)(e0 + (size_t)4 * 2 * DFF + DFF); } }
        else { ng = *(const u32x4*)(e0 + (size_t)1 * 2 * DFF); nv = *(const u32x4*)(e0 + (size_t)1 * 2 * DFF + DFF);
            if (!tok_first(row)) { pg = *(const u32x4*)(e0 - (size_t)1 * 2 * DFF); pv = *(const u32x4*)(e0 - (size_t)1 * 2 * DFF + DFF); } }
        float a0[8], a1[8], a2[8], b0[8], b1[8], b2[8], o[8];
        unpack8(pg, a0); unpack8(cg_, a1); unpack8(ng, a2); unpack8(pv, b0); unpack8(cv, b1); unpack8(nv, b2);
#pragma unroll
        for (int hlf = 0; hlf < 2; ++hlf) {
            const f32x4 w0g = *(const f32x4*)(cw + c0 + 4 * hlf), w1g = *(const f32x4*)(cw + UPW + c0 + 4 * hlf), w2g = *(const f32x4*)(cw + 2 * UPW + c0 + 4 * hlf), bgv = *(const f32x4*)(cb + c0 + 4 * hlf);
            const f32x4 w0v = *(const f32x4*)(cw + DFF + c0 + 4 * hlf), w1v = *(const f32x4*)(cw + UPW + DFF + c0 + 4 * hlf), w2v = *(const f32x4*)(cw + 2 * UPW + DFF + c0 + 4 * hlf), bvv = *(const f32x4*)(cb + DFF + c0 + 4 * hlf);
#pragma unroll
            for (int j = 0; j < 4; ++j) { const int q = 4 * hlf + j; const float gt = bgv[j] + w0g[j] * a0[q] + w1g[j] * a1[q] + w2g[j] * a2[q]; const float vl = bvv[j] + w0v[j] * b0[q] + w1v[j] * b1[q] + w2v[j] * b2[q]; o[q] = siluf_(gt) * vl; } }
        *(u32x4*)(act + (size_t)row * DFF + c0) = pack8(o);
    }
}
template <class Epi> __device__ __forceinline__ void run_gemm(unsigned char* shm, const bf16_t* A, const bf16_t* Bt, int M, int N, int K, const Epi& E) {
    asm volatile("" : "+s"(M), "+s"(N), "+s"(K));
    pg8::Gemm g; g.A = A; g.Bt = Bt; g.M = M; g.N = N; g.K = K;
    pg8::StaticOrder S; S.init(M, N, (int)gridDim.x, (int)blockIdx.x);
    pg8::gemm_phase<Epi, pg8::StaticOrder, GEMM_ALIGN_EPI, GEMM_SP2>((PG8_LAS unsigned char*)shm, g, S, E);
}

__device__ __forceinline__ void tr_job(const float* W, int K, int N, int NP, const float* scale, bf16_t* dst, float* tile, bool permup) {
    int tid_ = ltid(); const int tid = tid_, nnb = NP / 64, nt = (K / 64) * nnb;
    for (int t = blockIdx.x; t < nt; t += gridDim.x) {
        const int kb = t / nnb, nb = t % nnb, k0 = kb * 64, n0 = nb * 64;
#pragma unroll
        for (int i = 0; i < 8; ++i) { const int kk = i * 8 + (tid >> 6), n = n0 + (tid & 63); float v = (n < N) ? W[(size_t)(k0 + kk) * N + n] : 0.f; if (scale) v *= scale[k0 + kk]; tile[kk * 65 + (tid & 63)] = v; }
        __syncthreads();
        { const int nn = tid >> 3, c = tid & 7; const float* s = tile + (8 * c) * 65 + nn;
          u32x4 o; o.x = pk2(s[0], s[65]); o.y = pk2(s[130], s[195]); o.z = pk2(s[260], s[325]); o.w = pk2(s[390], s[455]);
          int nrow = n0 + nn; if (permup) { const int hv = nrow >= DFF ? 1 : 0, chn = nrow - hv * DFF; nrow = (chn >> 7) * 256 + hv * 128 + (chn & 127); }
          *(u32x4*)(dst + (size_t)nrow * K + k0 + 8 * c) = o; }
        __syncthreads();
    }
}
__device__ __forceinline__ void prep_weights(const Ctx& P, int layer, unsigned char* shm) {
    unsigned char* ws = P.ws(); float* tile = (float*)shm; int tid_ = ltid(); const int tid = tid_, lane = tid & 63, wave = tid >> 6;
#pragma unroll 1
    for (int job = 0; job < 7; ++job) {
        const float* W; const float* sc = nullptr; int K, N, NP; bf16_t* dst;
        if (job == 0) { W = P.in(I_FFN_UP) + (size_t)layer * 1024 * UPW; K = 1024; N = UPW; NP = UPW; sc = P.in(I_NORM_FFN) + layer * 1024; dst = (bf16_t*)(ws + woff(W_WUP, layer)); }
        else if (job == 1) { W = P.in(I_FFN_DOWN) + (size_t)layer * DFF * 1024; K = DFF; N = 1024; NP = 1024; dst = (bf16_t*)(ws + woff(W_WDOWN, layer)); }
        else if (job == 2) { W = P.in(I_W_IN) + (size_t)layer * 1024 * INW; K = 1024; N = INW; NP = INP; sc = P.in(I_NORM_MIX) + layer * 1024; dst = (bf16_t*)(ws + woff(W_WIN, layer)); }
        else if (job == 3) { W = P.in(I_W_OUT) + (size_t)layer * 1024 * 1024; K = 1024; N = 1024; NP = 1024; dst = (bf16_t*)(ws + woff(W_WOUT, layer)); }
        else if (job == 4) { W = P.in(I_PLE_GATE) + (size_t)layer * 1024 * 1024; K = 1024; N = 1024; NP = 1024; sc = P.in(I_PLE_NORM) + layer * 1024; dst = (bf16_t*)(ws + woff(W_WG, layer)); }
        else if (job == 5) { W = P.in(I_PLE_PROJ) + (size_t)layer * 256 * 1024; K = 256; N = 1024; NP = 1024; dst = (bf16_t*)(ws + woff(W_WP, layer)); }
        else { W = P.in(I_S5_GLUW) + (size_t)layer * 256 * 256; K = 256; N = 256; NP = 256; dst = (bf16_t*)(ws + woff(W_GLU, layer)); }
        tr_job(W, K, N, NP, sc, dst, tile, job == 0);
    }
    const size_t gtid = (size_t)blockIdx.x * 512 + tid, gthreads = (size_t)gridDim.x * 512;
    {
        const float* src = P.in(I_SGU_W) + (size_t)layer * 65536; bf16_t* dst = (bf16_t*)(ws + woff(W_SGU, layer));
        for (size_t i = gtid; i < 65536 / 8; i += gthreads) { const f32x4 a = *(const f32x4*)(src + i * 8), b = *(const f32x4*)(src + i * 8 + 4);
            u32x4 o; o.x = pk2(a[0], a[1]); o.y = pk2(a[2], a[3]); o.z = pk2(b[0], b[1]); o.w = pk2(b[2], b[3]); *(u32x4*)(dst + i * 8) = o; }
    }
    {
        f32x2v* ab = (f32x2v*)(ws + woff(W_AB, layer)); f32x2v* abL = (f32x2v*)(ws + woff(W_ABL, layer)); bf16_t* bop = (bf16_t*)(ws + woff(W_BOP, layer)); bf16_t* cop = (bf16_t*)(ws + woff(W_COP, layer));
        for (int it = blockIdx.x; it < 32; it += gridDim.x) { const int k = it >> 4, g = it & 15, p = tid & 63, q = tid >> 6;
            const float step = expf(P.in(I_S5_LSTEP)[(layer * 2 + k) * 16 + g]);
            const float lr = P.in(I_S5_LRE)[((size_t)(layer * 2 + k) * 16 + g) * 64 + p], li = P.in(I_S5_LIM)[((size_t)(layer * 2 + k) * 16 + g) * 64 + p];
            const float mag = expf(lr * step); const float rev = li * step * 0.15915494309189535f; const float fr1 = rev - floorf(rev);
            const float abr = mag * __builtin_amdgcn_cosf(fr1), abi = mag * __builtin_amdgcn_sinf(fr1);
            const float den = lr * lr + li * li; const float f_re = ((abr - 1.0f) * lr + abi * li) / den, f_im = (abi * lr - (abr - 1.0f) * li) / den;
            if (q == 0) { f32x2v t; t.x = abr; t.y = abi; ab[(k * 16 + g) * 64 + p] = t;
                const float magL = expf(lr * step * 128.0f); const float revL = rev * 128.0f; const float frL = revL - floorf(revL);
                f32x2v tl; tl.x = magL * __builtin_amdgcn_cosf(frL); tl.y = magL * __builtin_amdgcn_sinf(frL); abL[(k * 16 + g) * 64 + p] = tl; }
#pragma unroll
            for (int cc = 0; cc < 2; ++cc) { const int c = 2 * q + cc;
                const float br = P.in(I_S5_BRE)[(((size_t)layer * 16 + g) * 64 + p) * 16 + c], bi = P.in(I_S5_BIM)[(((size_t)layer * 16 + g) * 64 + p) * 16 + c];
                bop[((size_t)(k * 16 + g) * 128 + p) * 16 + c] = f2bf(f_re * br - f_im * bi);
                bop[((size_t)(k * 16 + g) * 128 + 64 + p) * 16 + c] = f2bf(f_re * bi + f_im * br); }
            if (k == 0) {
#pragma unroll
                for (int j = 0; j < 4; ++j) { const int e = tid * 4 + j, i = e >> 7, kk = e & 127;
                    const float v = kk < 64 ? P.in(I_S5_CRE)[(((size_t)layer * 16 + g) * 16 + i) * 64 + kk] : -P.in(I_S5_CIM)[(((size_t)layer * 16 + g) * 16 + i) * 64 + (kk - 64)];
                    cop[((size_t)g * 16 + i) * 128 + kk] = f2bf(v); }
            }
        }
    }
}
__device__ __forceinline__ void pconv_phase(const Ctx& P, int layer) {
    unsigned char* ws = P.ws(); const int tid = ltid(); const size_t gtid = (size_t)blockIdx.x * 512 + tid, gthreads = (size_t)gridDim.x * 512;
    {
        bf16_t* dst = (bf16_t*)(ws + W_PBF);
        for (size_t i = gtid; i < (size_t)M_TOK * 32; i += gthreads) { const int row = (int)(i >> 5), cgi = (int)(i & 31);
            const float* src = row < MP ? P.in(I_PP) + ((size_t)layer * MP + row) * 256 : P.in(I_PS) + ((size_t)layer * (M_TOK - MP) + (row - MP)) * 256;
            const f32x4 a = *(const f32x4*)(src + cgi * 8), b = *(const f32x4*)(src + cgi * 8 + 4);
            u32x4 o; o.x = pk2(a[0], a[1]); o.y = pk2(a[2], a[3]); o.z = pk2(b[0], b[1]); o.w = pk2(b[2], b[3]); *(u32x4*)(dst + (size_t)row * 256 + cgi * 8) = o; }
    }
}
__device__ __forceinline__ void xinit_phase(const Ctx& P) {
    unsigned char* ws = P.ws(); const int tid = ltid(), lane = tid & 63, wave = tid >> 6;
    {
        bf16_t* xb = (bf16_t*)P.out(); float* part = (float*)(ws + W_PARTA);
        for (int row = blockIdx.x * 8 + wave; row < M_TOK; row += gridDim.x * 8) {
            const float* src = row < MP ? P.in(I_XP) + (size_t)row * 1024 : P.in(I_XS) + (size_t)(row - MP) * 1024;
            float ss = 0.f;
#pragma unroll
            for (int j = 0; j < 4; ++j) { const f32x4 v = ((const f32x4*)src)[lane + 64 * j];
                u32x2 w; w.x = pk2(v[0], v[1]); w.y = pk2(v[2], v[3]); ((u32x2*)(xb + (size_t)row * 1024))[lane + 64 * j] = w;
                ss += (v[0] * v[0] + v[1] * v[1]) + (v[2] * v[2] + v[3] * v[3]); }
            ss += __shfl_xor(ss, 1); ss += __shfl_xor(ss, 2);
            if ((lane & 3) == 0) part[(size_t)row * 16 + (lane >> 2)] = ss;
        }
    }
}

template <bool TR, int LG> __device__ __forceinline__ void conv_silu_tile(const bf16_t* proj, int t0, bool hp, bool hn, int cc0, const float* cw, const float* cb, bf16_t* dst) {
    constexpr int NG = 1 << LG;
    constexpr int NQ = TR ? (NG / 8) : 1, NL = TR ? 2 : 4;
    const int tid = ltid();
    u32x4 rc[2][NL], rp[2][NL], rn[2][NL];
#define CST_LOAD(q_, s_) do { const int cc_ = cc0 + (TR ? ((tid >> 6) + 8 * (q_)) : (tid & 15)) * 8; \
        _Pragma("unroll") for (int i_ = 0; i_ < NL; ++i_) { const int l_ = TR ? ((tid & 63) + 64 * i_) : ((tid >> 4) + 32 * i_); const bf16_t* base_ = proj + (size_t)(t0 + l_) * INW + O_XBC + cc_; \
            const bool vp_ = (l_ > 0) | hp, vn_ = (l_ < 127) | hn; const u32x4 zz_ = {0u, 0u, 0u, 0u}; \
            rc[s_][i_] = *(const u32x4*)base_; const u32x4 tp_ = *(const u32x4*)(base_ - (vp_ ? INW : 0)), tn_ = *(const u32x4*)(base_ + (vn_ ? INW : 0)); rp[s_][i_] = vp_ ? tp_ : zz_; rn[s_][i_] = vn_ ? tn_ : zz_; } } while (0)
    CST_LOAD(0, 0);
#pragma unroll
    for (int q = 0; q < NQ; ++q) {
        const int cgi = TR ? ((tid >> 6) + 8 * q) : (tid & 15);
        const int cc = cc0 + cgi * 8;
        float w0[8], w1[8], w2[8], bb[8];
#pragma unroll
        for (int hlf = 0; hlf < 2; ++hlf) { const f32x4 a = *(const f32x4*)(cw + cc + 4 * hlf), b = *(const f32x4*)(cw + 1024 + cc + 4 * hlf), c = *(const f32x4*)(cw + 2048 + cc + 4 * hlf), d = *(const f32x4*)(cb + cc + 4 * hlf);
#pragma unroll
            for (int j = 0; j < 4; ++j) { w0[4 * hlf + j] = a[j]; w1[4 * hlf + j] = b[j]; w2[4 * hlf + j] = c[j]; bb[4 * hlf + j] = d[j]; } }
        if (q + 1 < NQ) CST_LOAD(q + 1, (q + 1) & 1);
#pragma unroll
        for (int i = 0; i < NL; ++i) {
            const int l = TR ? ((tid & 63) + 64 * i) : ((tid >> 4) + 32 * i);
            float xp[8], xc[8], xn[8], o[8];
            unpack8(rp[q & 1][i], xp); unpack8(rc[q & 1][i], xc); unpack8(rn[q & 1][i], xn);
#pragma unroll
            for (int j = 0; j < 8; ++j) o[j] = siluf_(bb[j] + w0[j] * xp[j] + w1[j] * xc[j] + w2[j] * xn[j]);
            if (TR) {
#pragma unroll
                for (int j = 0; j < 8; ++j) dst[(cgi * 8 + j) * 136 + l] = f2bf(o[j]);
            } else { *(u32x4*)(dst + l * 136 + cgi * 8) = pack8(o); }
        }
        if (q + 1 < NQ) asm volatile("" ::: "memory");
    }
#undef CST_LOAD
}

struct XhRegs { u32x4 rc[2], rp[2], rn[2]; };
__device__ __forceinline__ void xh_load(XhRegs& R, const bf16_t* proj, int t0, bool hp, bool hn, int cc0, int tid) {
    const int cc = cc0 + (tid >> 6) * 8;
#pragma unroll
    for (int i = 0; i < 2; ++i) { const int l = (tid & 63) + 64 * i; const bf16_t* base = proj + (size_t)(t0 + l) * INW + O_XBC + cc;
        const bool vp = (l > 0) | hp, vn = (l < 127) | hn; const u32x4 zz = {0u, 0u, 0u, 0u};
        R.rc[i] = *(const u32x4*)base; const u32x4 tp = *(const u32x4*)(base - (vp ? INW : 0)), tn = *(const u32x4*)(base + (vn ? INW : 0)); R.rp[i] = vp ? tp : zz; R.rn[i] = vn ? tn : zz; }
}
__device__ __forceinline__ void xh_store(const XhRegs& R, int cc0, const float* cw, const float* cb, bf16_t* dst, int tid) {
    const int cgi = tid >> 6, cc = cc0 + cgi * 8;
    float w0[8], w1[8], w2[8], bb[8];
#pragma unroll
    for (int hlf = 0; hlf < 2; ++hlf) { const f32x4 a = *(const f32x4*)(cw + cc + 4 * hlf), b = *(const f32x4*)(cw + 1024 + cc + 4 * hlf), c = *(const f32x4*)(cw + 2048 + cc + 4 * hlf), d = *(const f32x4*)(cb + cc + 4 * hlf);
#pragma unroll
        for (int j = 0; j < 4; ++j) { w0[4 * hlf + j] = a[j]; w1[4 * hlf + j] = b[j]; w2[4 * hlf + j] = c[j]; bb[4 * hlf + j] = d[j]; } }
#pragma unroll
    for (int i = 0; i < 2; ++i) { const int l = (tid & 63) + 64 * i; float xp[8], xc[8], xn[8];
        unpack8(R.rp[i], xp); unpack8(R.rc[i], xc); unpack8(R.rn[i], xn);
#pragma unroll
        for (int j = 0; j < 8; ++j) dst[(cgi * 8 + j) * 136 + l] = f2bf(siluf_(bb[j] + w0[j] * xp[j] + w1[j] * xc[j] + w2[j] * xn[j])); }
}

__device__ __forceinline__ void ssd_s1_item(const Ctx& P, int layer, int item, unsigned char* shm) {
    int tid_ = ltid(); const int tid = tid_, lane = tid & 63, wave = tid >> 6, fr = lane & 15, fq = lane >> 4;
    const int chunk = item >> 1, g = item & 1, t0 = chunk * 128;
    const bool hp = !tok_first(t0), hn = !tok_last(t0 + 127);
    unsigned char* ws = P.ws(); const bf16_t* proj = (const bf16_t*)(ws + R_PROJ); const float* dtb = (const float*)(ws + W_DT);
    bf16_t* Bt = (bf16_t*)shm; bf16_t* xT = (bf16_t*)(shm + 34816); float* WGT = (float*)(shm + 104448);
    const float* cw = P.in(I_SSD_CW) + (size_t)layer * 3 * 1024; const float* cb = P.in(I_SSD_CB) + (size_t)layer * 1024;
    conv_silu_tile<true, 4>(proj, t0, hp, hn, 512 + g * 128, cw, cb, Bt);
    conv_silu_tile<true, 5>(proj, t0, hp, hn, g * 256, cw, cb, xT);
    const int hh = wave & 3, dir = wave >> 2, h = g * 4 + hh;
    {
        const float bias = P.in(I_SSD_DTB)[(layer * 2 + dir) * 8 + h], a = -expf(P.in(I_SSD_ALOG)[(layer * 2 + dir) * 8 + h]);
        const int l0 = 2 * lane;
        const float d0 = softplusf_(dtb[(size_t)(t0 + l0) * 16 + dir * 8 + h] + bias), d1 = softplusf_(dtb[(size_t)(t0 + l0 + 1) * 16 + dir * 8 + h] + bias);
        const float a0 = d0 * a, a1 = d1 * a;
        const float incl = wave_incl_scan(a0 + a1, lane); const float total = __shfl(incl, 63);
        const float cs1 = incl, cs0 = incl - a1;
        float w0, w1;
        if (dir == 0) { w0 = d0 * __expf(total - cs0); w1 = d1 * __expf(total - cs1); }
        else { w0 = d0 * __expf(cs0 - a0); w1 = d1 * __expf(cs0); }
        WGT[wave * 128 + l0] = w0; WGT[wave * 128 + l0 + 1] = w1;
        if (lane == 0) ((float*)(ws + W_DECAY))[(chunk * 2 + dir) * 8 + h] = __expf(total);
    }
    __syncthreads();
    f32x4 acc[4][8];
#pragma unroll
    for (int i = 0; i < 4; ++i)
#pragma unroll
        for (int j = 0; j < 8; ++j) acc[i][j] = (f32x4){0.f, 0.f, 0.f, 0.f};
#pragma unroll
    for (int ks = 0; ks < 4; ++ks) {
        const f32x4 wa = *(const f32x4*)(WGT + wave * 128 + ks * 32 + fq * 8), wb = *(const f32x4*)(WGT + wave * 128 + ks * 32 + fq * 8 + 4);
        bf16x8 af[4];
#pragma unroll
        for (int i = 0; i < 4; ++i) { const u32x4 r = *(const u32x4*)(xT + (hh * 64 + 16 * i + fr) * 136 + ks * 32 + fq * 8);
            u32x4 s; s.x = pk2(bflo(r.x) * wa[0], bfhi(r.x) * wa[1]); s.y = pk2(bflo(r.y) * wa[2], bfhi(r.y) * wa[3]); s.z = pk2(bflo(r.z) * wb[0], bfhi(r.z) * wb[1]); s.w = pk2(bflo(r.w) * wb[2], bfhi(r.w) * wb[3]);
            af[i] = __builtin_bit_cast(bf16x8, s); }
#pragma unroll
        for (int j = 0; j < 8; ++j) { const bf16x8 bfj = *(const bf16x8*)(Bt + prow(j, fr) * 136 + ks * 32 + fq * 8);
#pragma unroll
            for (int i = 0; i < 4; ++i) acc[i][j] = MFMA32(bfj, af[i], acc[i][j]); }
    }
    bf16_t* st = (bf16_t*)(ws + R_STATES) + ((size_t)(chunk * 2 + dir) * 8 + h) * 8192;
#pragma unroll
    for (int i = 0; i < 4; ++i)
#pragma unroll
        for (int jj = 0; jj < 4; ++jj) { u32x4 w; w.x = pk2(acc[i][2 * jj][0], acc[i][2 * jj][1]); w.y = pk2(acc[i][2 * jj][2], acc[i][2 * jj][3]); w.z = pk2(acc[i][2 * jj + 1][0], acc[i][2 * jj + 1][1]); w.w = pk2(acc[i][2 * jj + 1][2], acc[i][2 * jj + 1][3]);
            *(u32x4*)(st + (16 * i + fr) * 128 + 32 * jj + 8 * fq) = w; }
    __syncthreads();
}

__device__ __forceinline__ void ssd_scan_item(const Ctx& P, int item) {
    int tid_ = ltid(); const int tid = tid_; unsigned char* ws = P.ws();
    const int sp = item >> 5, rem = item & 31; const int seq = sp < 2 ? 16 + sp : sp - 2; const int dir = rem >> 4, h = (rem >> 1) & 7, ps = rem & 1;
    const int nC = seq < 16 ? 16 : 64, cbase = seq < 16 ? seq * 16 : 256 + (seq - 16) * 64;
    const int p = ps * 32 + (tid >> 4), ng = tid & 15;
    bf16_t* states = (bf16_t*)(ws + R_STATES); const float* decay = (const float*)(ws + W_DECAY);
    float run[8];
#pragma unroll
    for (int j = 0; j < 8; ++j) run[j] = 0.f;
    {
        long sstride = dir == 0 ? (long)(2 * 8 * 8192) : -(long)(2 * 8 * 8192);
        int dstride = dir == 0 ? 16 : -16;
        asm volatile("" : "+v"(sstride), "+v"(dstride));
        const int cfirst = cbase + (dir == 0 ? 0 : nC - 1);
        bf16_t* a0 = states + ((size_t)(cfirst * 2 + dir) * 8 + h) * 8192 + p * 128 + ng * 8;
        const float* d0 = decay + (cfirst * 2 + dir) * 8 + h;
        for (int c8 = 0; c8 < nC; c8 += 8) {
            u32x4 v[8]; float dc[8];
#pragma unroll
            for (int i = 0; i < 8; ++i) { v[i] = *(const u32x4*)(a0 + i * sstride); dc[i] = d0[i * dstride]; }
#pragma unroll
            for (int i = 0; i < 8; ++i) { float sv[8]; unpack8(v[i], sv); if (P.rep == 0) *(u32x4*)(a0 + i * sstride) = pack8(run);
#pragma unroll
                for (int j = 0; j < 8; ++j) run[j] = run[j] * dc[i] + sv[j]; }
            a0 += 8 * sstride; d0 += 8 * dstride;
        }
    }
}

#define S3_PRELOAD(hq) do { xh_load(XR, proj, t0, hp, hn, g * 256 + (hq) * 64, tid); \
        const bf16_t* sf_ = states + ((size_t)(chunk * 2 + 0) * 8 + g * 4 + (hq)) * 8192; const bf16_t* sb_ = states + ((size_t)(chunk * 2 + 1) * 8 + g * 4 + (hq)) * 8192; \
        _Pragma("unroll") for (int i_ = 0; i_ < 2; ++i_) { const int it_ = tid + 512 * i_, p_ = it_ >> 4, c_ = it_ & 15; hfr[i_] = *(const u32x4*)(sf_ + p_ * 128 + c_ * 8); hbr[i_] = *(const u32x4*)(sb_ + p_ * 128 + c_ * 8); } } while (0)
__device__ __forceinline__ void ssd_s3_item(const Ctx& P, int layer, int item, unsigned char* shm) {
    int tid_ = ltid(); const int tid = tid_, lane = tid & 63, wave = tid >> 6, fr = lane & 15, fq = lane >> 4;
    const int chunk = item >> 1, g = item & 1, t0 = chunk * 128;
    const bool hp = !tok_first(t0), hn = !tok_last(t0 + 127);
    unsigned char* ws = P.ws(); const bf16_t* proj = (const bf16_t*)(ws + R_PROJ); const float* dtb = (const float*)(ws + W_DT);
    bf16_t* Cn = (bf16_t*)shm; bf16_t* BW = (bf16_t*)(shm + 34816); bf16_t* xTh = (bf16_t*)(shm + 69632); bf16_t* Hf = (bf16_t*)(shm + 87040); bf16_t* Hb = (bf16_t*)(shm + 104448);
    float* CSF = (float*)(shm + 121856); float* RCS = (float*)(shm + 123904); float* DTF = (float*)(shm + 125952); float* DTB = (float*)(shm + 128000);
    const float* cw = P.in(I_SSD_CW) + (size_t)layer * 3 * 1024; const float* cb = P.in(I_SSD_CB) + (size_t)layer * 1024;
    const bf16_t* states = (const bf16_t*)(ws + R_STATES);
    XhRegs XR; u32x4 hfr[2], hbr[2];
    S3_PRELOAD(0);
    conv_silu_tile<false, 4>(proj, t0, hp, hn, 512 + 256 + g * 128, cw, cb, Cn);
    conv_silu_tile<false, 4>(proj, t0, hp, hn, 512 + g * 128, cw, cb, BW);
    {
        const int hh = wave & 3, dir = wave >> 2, h = g * 4 + hh;
        const float bias = P.in(I_SSD_DTB)[(layer * 2 + dir) * 8 + h], a = -expf(P.in(I_SSD_ALOG)[(layer * 2 + dir) * 8 + h]);
        const int l0 = 2 * lane;
        const float d0 = softplusf_(dtb[(size_t)(t0 + l0) * 16 + dir * 8 + h] + bias), d1 = softplusf_(dtb[(size_t)(t0 + l0 + 1) * 16 + dir * 8 + h] + bias);
        const float a0 = d0 * a, a1 = d1 * a;
        const float incl = wave_incl_scan(a0 + a1, lane); const float total = __shfl(incl, 63);
        const float cs1 = incl, cs0 = incl - a1;
        if (dir == 0) { CSF[hh * 128 + l0] = cs0; CSF[hh * 128 + l0 + 1] = cs1; DTF[hh * 128 + l0] = d0; DTF[hh * 128 + l0 + 1] = d1; }
        else { RCS[hh * 128 + l0] = total - (cs0 - a0); RCS[hh * 128 + l0 + 1] = total - cs0; DTB[hh * 128 + l0] = d0; DTB[hh * 128 + l0 + 1] = d1; }
    }
    __syncthreads();
    const int l = 16 * wave + fr;
    f32x4 cbm[8];
#pragma unroll
    for (int j = 0; j < 8; ++j) cbm[j] = (f32x4){0.f, 0.f, 0.f, 0.f};
#pragma unroll
    for (int ks = 0; ks < 4; ++ks) { const bf16x8 sec = *(const bf16x8*)(Cn + l * 136 + ks * 32 + fq * 8);
#pragma unroll
        for (int j = 0; j < 8; ++j) { const bf16x8 fst = *(const bf16x8*)(BW + (16 * j + fr) * 136 + ks * 32 + fq * 8); cbm[j] = MFMA32(fst, sec, cbm[j]); } }
    __syncthreads();
    float ssq = 0.f;
    bf16_t* mix = (bf16_t*)(ws + R_MIX);
#pragma unroll 1
    for (int hh = 0; hh < 4; ++hh) {
        const int h = g * 4 + hh;
        xh_store(XR, g * 256 + hh * 64, cw, cb, xTh, tid);
#pragma unroll
        for (int i = 0; i < 2; ++i) { const int it = tid + 512 * i, p = it >> 4, c = it & 15; *(u32x4*)(Hf + p * 136 + c * 8) = hfr[i]; *(u32x4*)(Hb + p * 136 + c * 8) = hbr[i]; }
        {
            int lq = l; asm volatile("" : "+v"(lq));
            const float cfl = CSF[hh * 128 + l], rcl = RCS[hh * 128 + l];
#pragma unroll
            for (int j = 0; j < 8; ++j) { float wv[4];
                const int s0 = 16 * j + 4 * fq;
                const f32x4 csf4 = *(const f32x4*)(CSF + hh * 128 + s0), dtf4 = *(const f32x4*)(DTF + hh * 128 + s0), rcs4 = *(const f32x4*)(RCS + hh * 128 + s0), dtb4 = *(const f32x4*)(DTB + hh * 128 + s0);
#pragma unroll
                for (int r = 0; r < 4; ++r) { const int s = s0 + r;
                    const float ef = (s <= lq) ? __expf(cfl - csf4[r]) * dtf4[r] : 0.f;
                    const float eb = (s >= lq) ? __expf(rcl - rcs4[r]) * dtb4[r] : 0.f;
                    wv[r] = cbm[j][r] * (ef + eb); }
                u32x2 w; w.x = pk2(wv[0], wv[1]); w.y = pk2(wv[2], wv[3]); *(u32x2*)(BW + l * 136 + 16 * j + 4 * fq) = w; }
        }
        __syncthreads();
        if (hh < 3) S3_PRELOAD(hh + 1);
        f32x4 ya[4], tf[4], tb[4];
#pragma unroll
        for (int j = 0; j < 4; ++j) { ya[j] = (f32x4){0.f, 0.f, 0.f, 0.f}; tf[j] = ya[j]; tb[j] = ya[j]; }
#pragma unroll
        for (int ks = 0; ks < 4; ++ks) {
            const bf16x8 secC = *(const bf16x8*)(Cn + l * 136 + ks * 32 + fq * 8), secW = *(const bf16x8*)(BW + l * 136 + ks * 32 + fq * 8);
#pragma unroll
            for (int j = 0; j < 4; ++j) {
                const bf16x8 f1 = *(const bf16x8*)(Hf + prow(j, fr) * 136 + ks * 32 + fq * 8), f2 = *(const bf16x8*)(Hb + prow(j, fr) * 136 + ks * 32 + fq * 8), f3 = *(const bf16x8*)(xTh + prow(j, fr) * 136 + ks * 32 + fq * 8);
                tf[j] = MFMA32(f1, secC, tf[j]); tb[j] = MFMA32(f2, secC, tb[j]); ya[j] = MFMA32(f3, secW, ya[j]); }
        }
        {
            const float ef = __expf(CSF[hh * 128 + l]), eb = __expf(RCS[hh * 128 + l]), dsk = P.in(I_SSD_D)[layer * 8 + h];
#pragma unroll
            for (int jj = 0; jj < 2; ++jj) { const int p0 = 32 * jj + 8 * fq;
                float z[8], yv[8]; unpack8(*(const u32x4*)(proj + (size_t)(t0 + l) * INW + h * 64 + p0), z);
#pragma unroll
                for (int e = 0; e < 8; ++e) { const int j = 2 * jj + (e >> 2), r = e & 3; const float xs = bf2f(xTh[(p0 + e) * 136 + l]);
                    const float y = ya[j][r] + tf[j][r] * ef + tb[j][r] * eb + dsk * xs; yv[e] = y * siluf_(z[e]); ssq += yv[e] * yv[e]; }
                *(u32x4*)(mix + (size_t)(t0 + l) * 1024 + h * 64 + p0) = pack8(yv); }
        }
        __syncthreads();
    }
    ssq += __shfl_xor(ssq, 16); ssq += __shfl_xor(ssq, 32);
    if (fq == 0) ((float*)(ws + W_SSQ))[(size_t)(t0 + l) * 2 + g] = ssq;
}

template <bool FULL> __device__ __forceinline__ void s5_item(const Ctx& P, int layer, int item, unsigned char* shm) {
    int tid_ = ltid(); const int tid = tid_, lane = tid & 63, wave = tid >> 6, fr = lane & 15, fq = lane >> 4;
    const int sq = item >> 2, k = (item >> 1) & 1, g = (item & 1) * 8 + wave;
    unsigned char* ws = P.ws(); const bf16_t* proj = (const bf16_t*)(ws + R_PROJ);
    const f32x2v* ab = (const f32x2v*)(ws + woff(W_AB, layer)); const bf16_t* bop = (const bf16_t*)(ws + woff(W_BOP, layer)); const bf16_t* cop = (const bf16_t*)(ws + woff(W_COP, layer));
    bf16_t* S = (bf16_t*)(shm + wave * 4352);
    float are[4], aim[4], sre[4], sim[4]; bf16x4 bre[4], bim[4]; bf16x8 cf[4];
    const int seg = sq * 4 + fq;
#pragma unroll
    for (int j = 0; j < 4; ++j) { const f32x2v t = ab[(k * 16 + g) * 64 + 16 * j + fr]; are[j] = t.x; aim[j] = t.y;
        bre[j] = *(const bf16x4*)(bop + ((size_t)(k * 16 + g) * 128 + 16 * j + fr) * 16 + fq * 4);
        bim[j] = *(const bf16x4*)(bop + ((size_t)(k * 16 + g) * 128 + 64 + 16 * j + fr) * 16 + fq * 4);
        if (FULL) { cf[j] = *(const bf16x8*)(cop + ((size_t)g * 16 + fr) * 128 + j * 32 + fq * 8);
            const f32x2v hi = ((const f32x2v*)(ws + W_HIN))[((size_t)(seg * 2 + k) * 16 + g) * 64 + 16 * j + fr]; sre[j] = hi.x; sim[j] = hi.y; }
        else { sre[j] = 0.f; sim[j] = 0.f; } }
    const int qa = fr >> 2, ra = fr & 3;
    const bf16_t* abase = proj + O_S5 + g * 16 + fq * 4;
    const int tokA0 = (sq * 4 + qa) * 128;
    bf16_t* yb = (bf16_t*)(ws + R_S5Y) + (size_t)k * M_TOK * 256 + g * 16 + fr;
    bf16x4 afr = *(const bf16x4*)(abase + (size_t)(tokA0 + (k == 0 ? ra : 127 - ra)) * INW);
    for (int tb = 0; tb < 32; ++tb) {
        const bf16x4 acur = afr;
        if (tb < 31) { const int tau = (tb + 1) * 4 + ra; afr = *(const bf16x4*)(abase + (size_t)(tokA0 + (k == 0 ? tau : 127 - tau)) * INW); }
        f32x4 ure[4], uim[4];
#pragma unroll
        for (int j = 0; j < 4; ++j) { ure[j] = MFMA16(acur, bre[j], ((f32x4){0.f, 0.f, 0.f, 0.f})); uim[j] = MFMA16(acur, bim[j], ((f32x4){0.f, 0.f, 0.f, 0.f})); }
#pragma unroll
        for (int r = 0; r < 4; ++r)
#pragma unroll
            for (int j = 0; j < 4; ++j) { const float nre = are[j] * sre[j] - aim[j] * sim[j] + ure[j][r], nim = are[j] * sim[j] + aim[j] * sre[j] + uim[j][r]; sre[j] = nre; sim[j] = nim;
                if (FULL) { S[(4 * fq + r) * 136 + 16 * j + fr] = f2bf(nre); S[(4 * fq + r) * 136 + 64 + 16 * j + fr] = f2bf(nim); } }
        if (FULL) {
            WAVE_LDS_FENCE();
            f32x4 ya = (f32x4){0.f, 0.f, 0.f, 0.f};
#pragma unroll
            for (int ks = 0; ks < 4; ++ks) { const bf16x8 a2 = *(const bf16x8*)(S + fr * 136 + ks * 32 + fq * 8); ya = MFMA32(a2, cf[ks], ya); }
            WAVE_LDS_FENCE();
#pragma unroll
            for (int r = 0; r < 4; ++r) { const int tau = tb * 4 + r; const int tok = seg * 128 + (k == 0 ? tau : 127 - tau); yb[(size_t)tok * 256] = f2bf(ya[r]); }
        }
    }
    if (!FULL) {
        f32x2v* hl = (f32x2v*)(ws + W_HLOC);
#pragma unroll
        for (int j = 0; j < 4; ++j) { f32x2v t; t.x = sre[j]; t.y = sim[j]; hl[((size_t)(seg * 2 + k) * 16 + g) * 64 + 16 * j + fr] = t; }
    }
}
__device__ __forceinline__ void s5_carry(const Ctx& P, int layer) {
    unsigned char* ws = P.ws(); const f32x2v* abL = (const f32x2v*)(ws + woff(W_ABL, layer)); const f32x2v* hl = (const f32x2v*)(ws + W_HLOC); f32x2v* hin = (f32x2v*)(ws + W_HIN);
    for (int idx = blockIdx.x * 512 + ltid(); idx < 18 * 2048; idx += gridDim.x * 512) {
        const int p = idx & 63, g = (idx >> 6) & 15, k = (idx >> 10) & 1, seq = idx >> 11;
        const int nS = seq < 16 ? 16 : 64, sbase = seq < 16 ? seq * 16 : 256 + (seq - 16) * 64;
        const f32x2v a = abL[(k * 16 + g) * 64 + p]; float rr = 0.f, ri = 0.f;
        for (int s = 0; s < nS; ++s) { const int sg = sbase + (k == 0 ? s : nS - 1 - s); const size_t o = ((size_t)(sg * 2 + k) * 16 + g) * 64 + p;
            const f32x2v v = hl[o]; f32x2v t; t.x = rr; t.y = ri; hin[o] = t;
            const float nr = a.x * rr - a.y * ri + v.x, ni = a.x * ri + a.y * rr + v.y; rr = nr; ri = ni; }
    }
}

__device__ __forceinline__ void sgu_item(const Ctx& P, int layer, int chunk, unsigned char* shm) {
    int tid_ = ltid(); const int tid = tid_, lane = tid & 63, wave = tid >> 6, fr = lane & 15, fq = lane >> 4, t0 = chunk * 128;
    unsigned char* ws = P.ws(); const bf16_t* proj = (const bf16_t*)(ws + R_PROJ); bf16_t* vT = (bf16_t*)shm;
    {
        const int l = tid >> 2, part = tid & 3; const bf16_t* src = proj + (size_t)(t0 + l) * INW + O_SGU + 256 + part * 64;
        float v[64]; float s = 0.f;
#pragma unroll
        for (int i = 0; i < 8; ++i) { float t[8]; unpack8(*(const u32x4*)(src + i * 8), t);
#pragma unroll
            for (int j = 0; j < 8; ++j) { v[i * 8 + j] = geluf_(t[j]); s += v[i * 8 + j]; } }
        s += __shfl_xor(s, 1); s += __shfl_xor(s, 2); const float mean = s * (1.0f / 256.0f); float q = 0.f;
#pragma unroll
        for (int i = 0; i < 64; ++i) { v[i] -= mean; q += v[i] * v[i]; }
        q += __shfl_xor(q, 1); q += __shfl_xor(q, 2); const float rstd = rsqrtf(q * (1.0f / 256.0f) + 1e-5f);
        const float* nw = P.in(I_SGU_NW) + layer * 256 + part * 64; const float* nb = P.in(I_SGU_NB) + layer * 256 + part * 64;
#pragma unroll
        for (int i = 0; i < 64; ++i) vT[(part * 64 + i) * 136 + l] = f2bf(v[i] * rstd * nw[i] + nb[i]);
    }
    __syncthreads();
    const int t = 16 * wave + fr; const bf16_t* Wsg = (const bf16_t*)(ws + woff(W_SGU, layer));
    f32x4 acc[4][4];
#pragma unroll
    for (int h = 0; h < 4; ++h)
#pragma unroll
        for (int j = 0; j < 4; ++j) acc[h][j] = (f32x4){0.f, 0.f, 0.f, 0.f};
#pragma unroll
    for (int h = 0; h < 4; ++h)
#pragma unroll
        for (int ks = 0; ks < 4; ++ks) { const bf16x8 sec = *(const bf16x8*)(Wsg + ((size_t)h * 128 + t) * 128 + ks * 32 + fq * 8);
#pragma unroll
            for (int j = 0; j < 4; ++j) { const bf16x8 fst = *(const bf16x8*)(vT + (h * 64 + 16 * j + fr) * 136 + ks * 32 + fq * 8); acc[h][j] = MFMA32(fst, sec, acc[h][j]); } }
    float ss = 0.f;
#pragma unroll
    for (int h = 0; h < 4; ++h) { const float bs = P.in(I_SGU_B)[(layer * 4 + h) * 128 + t];
#pragma unroll
        for (int j = 0; j < 4; ++j) { const int ch = h * 64 + 16 * j + 4 * fq; const u32x2 uw = *(const u32x2*)(proj + (size_t)(t0 + t) * INW + O_SGU + ch);
            const float u0 = geluf_(bflo(uw.x)), u1 = geluf_(bfhi(uw.x)), u2 = geluf_(bflo(uw.y)), u3 = geluf_(bfhi(uw.y));
            f32x4 o; o[0] = u0 * (acc[h][j][0] + bs); o[1] = u1 * (acc[h][j][1] + bs); o[2] = u2 * (acc[h][j][2] + bs); o[3] = u3 * (acc[h][j][3] + bs);
            acc[h][j] = o; ss += (o[0] * o[0] + o[1] * o[1]) + (o[2] * o[2] + o[3] * o[3]); } }
    ss += __shfl_xor(ss, 16); ss += __shfl_xor(ss, 32);
    const float rstd = rsqrtf(ss * (1.0f / 256.0f) + 1e-6f); bf16_t* mix = (bf16_t*)(ws + R_MIX); const float* onw = P.in(I_SGU_ONORM) + layer * 256;
#pragma unroll
    for (int h = 0; h < 4; ++h)
#pragma unroll
        for (int j = 0; j < 4; ++j) { const int ch = h * 64 + 16 * j + 4 * fq; const f32x4 w4 = *(const f32x4*)(onw + ch); const f32x4 o = acc[h][j];
            u32x2 w; w.x = pk2(o[0] * rstd * w4[0], o[1] * rstd * w4[1]); w.y = pk2(o[2] * rstd * w4[2], o[3] * rstd * w4[3]); *(u32x2*)(mix + (size_t)(t0 + t) * 1024 + 768 + ch) = w; }
    __syncthreads();
}

__device__ __forceinline__ void finalize_item(const Ctx& P, int layer, int tile, unsigned char* shm) {
    int tid_ = ltid(); const int tid = tid_, lane = tid & 63, wave = tid >> 6, fr = lane & 15, fq = lane >> 4, t0 = tile * 128;
    unsigned char* ws = P.ws(); const bf16_t* proj = (const bf16_t*)(ws + R_PROJ); bf16_t* mix = (bf16_t*)(ws + R_MIX);
    {
        const float* ssq = (const float*)(ws + W_SSQ); const float* nw = P.in(I_SSD_NORM) + layer * 512;
#pragma unroll 4
        for (int i = 0; i < 16; ++i) { const int it = tid + 512 * i, l = it >> 6, cgi = it & 63;
            const float rstd = rsqrtf((ssq[(size_t)(t0 + l) * 2] + ssq[(size_t)(t0 + l) * 2 + 1]) * (1.0f / 512.0f) + 1e-6f);
            bf16_t* ptr = mix + (size_t)(t0 + l) * 1024 + cgi * 8; float v[8]; unpack8(*(const u32x4*)ptr, v);
            const f32x4 wa = *(const f32x4*)(nw + cgi * 8), wb = *(const f32x4*)(nw + cgi * 8 + 4);
            v[0] *= rstd * wa[0]; v[1] *= rstd * wa[1]; v[2] *= rstd * wa[2]; v[3] *= rstd * wa[3]; v[4] *= rstd * wb[0]; v[5] *= rstd * wb[1]; v[6] *= rstd * wb[2]; v[7] *= rstd * wb[3];
            if (P.rep == 0) *(u32x4*)ptr = pack8(v); }
    }
    bf16_t* Yg = (bf16_t*)shm;
    {
        const bf16_t* yf = (const bf16_t*)(ws + R_S5Y); const bf16_t* ybk = yf + (size_t)M_TOK * 256; const float* dsk = P.in(I_S5_D) + layer * 256;
#pragma unroll 2
        for (int i = 0; i < 8; ++i) { const int it = tid + 512 * i, l = it >> 5, cgi = it & 31;
            float u[8], a[8], b[8], o[8]; unpack8(*(const u32x4*)(proj + (size_t)(t0 + l) * INW + O_S5 + cgi * 8), u);
            unpack8(*(const u32x4*)(yf + (size_t)(t0 + l) * 256 + cgi * 8), a); unpack8(*(const u32x4*)(ybk + (size_t)(t0 + l) * 256 + cgi * 8), b);
            const f32x4 da = *(const f32x4*)(dsk + cgi * 8), db = *(const f32x4*)(dsk + cgi * 8 + 4);
#pragma unroll
            for (int j = 0; j < 8; ++j) o[j] = geluf_(u[j] * (j < 4 ? da[j & 3] : db[j & 3]) + a[j] + b[j]);
            *(u32x4*)(Yg + l * 264 + cgi * 8) = pack8(o); }
    }
    __syncthreads();
    const int t = 16 * wave + fr; const bf16_t* glut = (const bf16_t*)(ws + woff(W_GLU, layer));
    f32x4 acc[16];
#pragma unroll
    for (int j = 0; j < 16; ++j) acc[j] = (f32x4){0.f, 0.f, 0.f, 0.f};
#pragma unroll 1
    for (int ks = 0; ks < 8; ++ks) { const bf16x8 sec = *(const bf16x8*)(Yg + t * 264 + ks * 32 + fq * 8);
#pragma unroll
        for (int j = 0; j < 16; ++j) { const bf16x8 fst = *(const bf16x8*)(glut + (size_t)(16 * j + fr) * 256 + ks * 32 + fq * 8); acc[j] = MFMA32(fst, sec, acc[j]); } }
    float ss = 0.f; const float* gb = P.in(I_S5_GLUB) + layer * 256;
#pragma unroll
    for (int j = 0; j < 16; ++j) { const int n0 = 16 * j + 4 * fq; const u32x2 yw = *(const u32x2*)(Yg + t * 264 + n0); const f32x4 b4 = *(const f32x4*)(gb + n0);
        f32x4 o; o[0] = bflo(yw.x) * sigmoidf_(acc[j][0] + b4[0]); o[1] = bfhi(yw.x) * sigmoidf_(acc[j][1] + b4[1]); o[2] = bflo(yw.y) * sigmoidf_(acc[j][2] + b4[2]); o[3] = bfhi(yw.y) * sigmoidf_(acc[j][3] + b4[3]);
        acc[j] = o; ss += (o[0] * o[0] + o[1] * o[1]) + (o[2] * o[2] + o[3] * o[3]); }
    ss += __shfl_xor(ss, 16); ss += __shfl_xor(ss, 32);
    const float rstd = rsqrtf(ss * (1.0f / 256.0f) + 1e-6f); const float* onw = P.in(I_S5_ONORM) + layer * 256;
#pragma unroll
    for (int j = 0; j < 16; ++j) { const int n0 = 16 * j + 4 * fq; const f32x4 w4 = *(const f32x4*)(onw + n0); const f32x4 o = acc[j];
        u32x2 w; w.x = pk2(o[0] * rstd * w4[0], o[1] * rstd * w4[1]); w.y = pk2(o[2] * rstd * w4[2], o[3] * rstd * w4[3]); if (P.rep == 0) *(u32x2*)(mix + (size_t)(t0 + t) * 1024 + 512 + n0) = w; }
    __syncthreads();
}

__device__ __forceinline__ void convact_phase(const Ctx& P, int layer, int slab) {
    unsigned char* ws = P.ws(); const bf16_t* up = (const bf16_t*)(ws + R_UP); bf16_t* act = (bf16_t*)(ws + R_ACT);
    const float* cw = P.in(I_FFN_CW) + (size_t)layer * 3 * UPW; const float* cb = P.in(I_FFN_CB) + (size_t)layer * UPW;
    const int R0 = slab * SLAB; constexpr int NCG = DFF / 8, RB = 16;
    for (int it = blockIdx.x * 512 + ltid(); it < (SLAB / RB) * NCG; it += gridDim.x * 512) {
        const int rb = it / NCG, cgi = it % NCG, c0 = cgi * 8, r0 = rb * RB;
        float wg[3][8], wv[3][8], bg[8], bv[8];
#pragma unroll
        for (int k = 0; k < 3; ++k)
#pragma unroll
            for (int hlf = 0; hlf < 2; ++hlf) { const f32x4 a = *(const f32x4*)(cw + k * UPW + c0 + 4 * hlf), b = *(const f32x4*)(cw + k * UPW + DFF + c0 + 4 * hlf);
#pragma unroll
                for (int j = 0; j < 4; ++j) { wg[k][4 * hlf + j] = a[j]; wv[k][4 * hlf + j] = b[j]; } }
#pragma unroll
        for (int hlf = 0; hlf < 2; ++hlf) { const f32x4 a = *(const f32x4*)(cb + c0 + 4 * hlf), b = *(const f32x4*)(cb + DFF + c0 + 4 * hlf);
#pragma unroll
            for (int j = 0; j < 4; ++j) { bg[4 * hlf + j] = a[j]; bv[4 * hlf + j] = b[j]; } }
        const u32x4 zz = {0u, 0u, 0u, 0u};
        u32x4 pg = zz, pv = zz;
        if (!tok_first(R0 + r0)) { pg = *(const u32x4*)(up + (size_t)(r0 - 1) * UPW + c0); pv = *(const u32x4*)(up + (size_t)(r0 - 1) * UPW + DFF + c0); }
        u32x4 cg_ = *(const u32x4*)(up + (size_t)r0 * UPW + c0), cv = *(const u32x4*)(up + (size_t)r0 * UPW + DFF + c0);
#pragma unroll 2
        for (int i = 0; i < RB; ++i) { const int r = r0 + i; u32x4 ng = zz, nv = zz;
            if (!tok_last(R0 + r)) { ng = *(const u32x4*)(up + (size_t)(r + 1) * UPW + c0); nv = *(const u32x4*)(up + (size_t)(r + 1) * UPW + DFF + c0); }
            float a0[8], a1[8], a2[8], b0[8], b1[8], b2[8], o[8];
            unpack8(pg, a0); unpack8(cg_, a1); unpack8(ng, a2); unpack8(pv, b0); unpack8(cv, b1); unpack8(nv, b2);
#pragma unroll
            for (int j = 0; j < 8; ++j) { const float gt = bg[j] + wg[0][j] * a0[j] + wg[1][j] * a1[j] + wg[2][j] * a2[j]; const float vl = bv[j] + wv[0][j] * b0[j] + wv[1][j] * b1[j] + wv[2][j] * b2[j]; o[j] = siluf_(gt) * vl; }
            *(u32x4*)(act + (size_t)r * DFF + c0) = pack8(o);
            pg = cg_; pv = cv; cg_ = ng; cv = nv; }
    }
}

__device__ __forceinline__ void final_phase(const Ctx& P) {
    const int lane = ltid() & 63, wave = ltid() >> 6; const float* part = (const float*)(P.ws() + W_PARTA); const float* fw = P.in(I_FINAL_NORM); const bf16_t* xb = (const bf16_t*)(P.ws() + R_XALT);
    for (int row = blockIdx.x * 8 + wave; row < M_TOK; row += gridDim.x * 8) { const float rs = row_rstd16(part, row);
#pragma unroll
        for (int j = 0; j < 4; ++j) { const u32x2 xw = ((const u32x2*)(xb + (size_t)row * 1024))[lane + 64 * j]; const f32x4 w = ((const f32x4*)fw)[lane + 64 * j];
            f32x4 v; v[0] = bflo(xw.x) * rs * w[0]; v[1] = bfhi(xw.x) * rs * w[1]; v[2] = bflo(xw.y) * rs * w[2]; v[3] = bfhi(xw.y) * rs * w[3];
            ((f32x4*)(P.out() + (size_t)row * 1024))[lane + 64 * j] = v; } }
}

#ifndef PHMASK
#define PHMASK 0xFFFFFFFFu
#endif
#define PHM(n) (((PHMASK) >> (n)) & 1u)
__device__ __forceinline__ void run_phase(const Ctx& P, int ph, unsigned char* shm) {
    unsigned char* ws = P.ws();
    if (ph == 0) { prep_weights(P, 0, shm); xinit_phase(P); return; }
    if (ph == N_PHASES - 1) { final_phase(P); return; }
    const int layer = (ph - 1) / PH_PER_LAYER, sub = (ph - 1) % PH_PER_LAYER;
    bf16_t* xbf = (bf16_t*)(ws + R_XBF); bf16_t* xalt = (bf16_t*)P.out();
    float* partA = (float*)(ws + W_PARTA); float* partB = (float*)(ws + W_PARTB);
    if (sub == 0) { EpiProj E; E.proj = (bf16_t*)(ws + R_PROJ); E.dt = (float*)(ws + W_DT); E.part = partA; run_gemm(shm, xalt, (const bf16_t*)(ws + woff(W_WIN, layer)), M_TOK, INP, 1024, E); }
    else if (sub == 1) {
        for (int it = blockIdx.x; it < 1536; it += gridDim.x) {
            if (it < 768) ssd_s1_item(P, layer, it, shm);
            else if (it < 1152) sgu_item(P, layer, it - 768, shm);
            else s5_item<false>(P, layer, it - 1152, shm);
        }
    }
    else if (sub == 2) {
        for (int it = blockIdx.x; it < 576; it += gridDim.x) ssd_scan_item(P, it);
        s5_carry(P, layer);
        pconv_phase(P, layer);
        if (layer + 1 < NLAYER) prep_weights(P, layer + 1, shm);
    }
    else if (sub == 3) {
        for (int it = blockIdx.x; it < 1152; it += gridDim.x) { if (it < 768) ssd_s3_item(P, layer, it, shm); else { s5_item<true>(P, layer, it - 768, shm); __syncthreads(); } }
    }
    else if (sub == 4) { for (int it = blockIdx.x; it < NCHUNK; it += gridDim.x) finalize_item(P, layer, it, shm); }
    else if (sub == 5) { EpiResid<false> E; E.xin = xalt; E.xout = xbf; E.part_out = partA; E.part_in = nullptr; E.e = nullptr; E.rep = P.rep; run_gemm(shm, (const bf16_t*)(ws + R_MIX), (const bf16_t*)(ws + woff(W_WOUT, layer)), M_TOK, 1024, 1024, E); }
    else if (sub == 6) { EpiUpConv E; E.act = (bf16_t*)(ws + R_UP); E.edge = (bf16_t*)(ws + W_EDGE); E.part = partA; E.cw = P.in(I_FFN_CW) + (size_t)layer * 3 * UPW; E.cb = P.in(I_FFN_CB) + (size_t)layer * UPW; E.xbuf = (unsigned*)(shm + 131072);
        run_gemm(shm, xbf, (const bf16_t*)(ws + woff(W_WUP, layer)), M_TOK, UPW, 1024, E); }
    else if (sub == 7) { ffn_fixup_phase(P, layer); }
    else if (sub == 8) {
        { EpiResid<false> E; E.xin = xbf; E.xout = xbf; E.part_out = partB; E.part_in = nullptr; E.e = nullptr; E.rep = P.rep; run_gemm(shm, (const bf16_t*)(ws + R_UP), (const bf16_t*)(ws + woff(W_WDOWN, layer)), M_TOK, 1024, DFF, E); }
        { EpiBf16S<false> E; E.O = (bf16_t*)(ws + R_E); E.ldc = 1024; E.part = nullptr; run_gemm(shm, (const bf16_t*)(ws + W_PBF), (const bf16_t*)(ws + woff(W_WP, layer)), M_TOK, 1024, 256, E); }
    }
    else { EpiResid<true> E; E.xin = xbf; E.xout = (layer == NLAYER - 1) ? (bf16_t*)(ws + R_XALT) : xalt; E.part_out = partA; E.part_in = partB; E.e = (const bf16_t*)(ws + R_E); E.rep = P.rep; run_gemm(shm, xbf, (const bf16_t*)(ws + woff(W_WG, layer)), M_TOK, 1024, 1024, E); }
}

#define XB_TMO      128
#define XB_XCNT(j)  (256  + 64 * (j))
#define XB_XSUB(j)  (1280 + 64 * (j))
#define XB_XGEN(j)  (2304 + 64 * (j))
#define XB_TOP      3328
#define XB_TOPGEN   3392
#define XCD_BAR_WORDS 3456
#define XB_SPIN_CAP (1u << 18)
#define LAS __attribute__((address_space(3)))

__device__ __forceinline__ unsigned xb_ld(unsigned* p)              { return __hip_atomic_load(p, __ATOMIC_RELAXED, __HIP_MEMORY_SCOPE_AGENT); }
__device__ __forceinline__ unsigned xb_add(unsigned* p, unsigned v) { return __hip_atomic_fetch_add(p, v, __ATOMIC_RELAXED, __HIP_MEMORY_SCOPE_AGENT); }
__device__ __forceinline__ unsigned xb_xcc_id() { return (unsigned)__builtin_amdgcn_s_getreg((3 << 11) | 20) & 0xFu; }
#define XB_SPIN(cond, bar) do { unsigned _sp = 0; while (cond) { __builtin_amdgcn_s_sleep(1); \
    if ((++_sp & 255u) == 0u) { if (xb_ld(&(bar)[XB_TMO])) break; if (_sp > XB_SPIN_CAP) { atomicAdd(&(bar)[XB_TMO], 1u); break; } } } } while (0)

struct XcdBarrier {
    unsigned* bar; unsigned x;
    volatile LAS unsigned* st;
};

__device__ __forceinline__ XcdBarrier xcd_barrier_post(unsigned* bar, volatile LAS unsigned* st) {
    XcdBarrier b; b.bar = bar; b.x = xb_xcc_id(); b.st = st;
    if (threadIdx.x == 0) (void)xb_add(&bar[XB_XCNT(b.x)], 1u);
    return b;
}
__device__ __forceinline__ void xcd_barrier_complete(unsigned* bar, unsigned x, unsigned& nloc, unsigned& nx) {
    const unsigned G = gridDim.x * gridDim.y * gridDim.z;
    unsigned sum, cnt, mine, sp = 0u;
    for (;;) {
        sum = 0u; cnt = 0u; mine = 0u;
#pragma unroll
        for (unsigned j = 0; j < 16; ++j) { const unsigned c = xb_ld(&bar[XB_XCNT(j)]); sum += c; cnt += (c > 0u) ? 1u : 0u; mine = (j == x) ? c : mine; }
        if (sum == G) break;
        __builtin_amdgcn_s_sleep(1);
        if ((++sp & 255u) == 0u) { if (xb_ld(&bar[XB_TMO])) break; if (sp > XB_SPIN_CAP) { atomicAdd(&bar[XB_TMO], 1u); break; } }
    }
    nloc = mine > 0u ? mine : 1u; nx = cnt > 0u ? cnt : 1u;
}

__device__ __forceinline__ void xcd_barrier(const XcdBarrier& b) {
    asm volatile("s_waitcnt vmcnt(0)" ::: "memory");
    __syncthreads();
    if (threadIdx.x == 0) {
        unsigned* bar = b.bar;
        __builtin_amdgcn_s_waitcnt(0);
        unsigned nloc = b.st[0], nx = b.st[1];
        if (nloc == 0u) { xcd_barrier_complete(bar, b.x, nloc, nx); b.st[0] = nloc; b.st[1] = nx; }
        const unsigned old = xb_add(&bar[XB_XSUB(b.x)], 1u);
        const unsigned gen = old / nloc;
        if (old + 1u == (gen + 1u) * nloc) {
            __builtin_amdgcn_fence(__ATOMIC_RELEASE, "agent");
            asm volatile("s_waitcnt vmcnt(0)" ::: "memory");
            const unsigned og = xb_add(&bar[XB_TOP], 1u);
            const unsigned tg = og / nx;
            if (og + 1u == (tg + 1u) * nx) xb_add(&bar[XB_TOPGEN], 1u);
            else XB_SPIN(xb_ld(&bar[XB_TOPGEN]) == tg, bar);
            __builtin_amdgcn_fence(__ATOMIC_ACQUIRE, "agent");
            xb_add(&bar[XB_XGEN(b.x)], 1u);
            asm volatile("s_waitcnt vmcnt(0)" ::: "memory");
        } else {
            XB_SPIN(xb_ld(&bar[XB_XGEN(b.x)]) == gen, bar);
            __builtin_amdgcn_fence(__ATOMIC_ACQUIRE, "agent");
            asm volatile("s_waitcnt vmcnt(0)" ::: "memory");
        }
    }
    __syncthreads();
}

__global__ void __launch_bounds__(512, 2) mega_fwd(Params P) {
    extern __shared__ __attribute__((aligned(16))) unsigned char shm[];
    cg::grid_group grid = cg::this_grid();
    if (P.ph_lo < 0) grid.sync();
    volatile LAS unsigned* st = (volatile LAS unsigned*)(shm + LDS_BYTES - 16);
    if (threadIdx.x == 0) { st[0] = 0u; st[1] = 0u; }
    __syncthreads();
    const XcdBarrier xb = xcd_barrier_post((unsigned*)(P.ws + W_BAR), st);
    for (int ph = P.ph_lo; ph < P.ph_hi; ++ph) {
        Ctx C; C.ka = (kaptr_t)__builtin_amdgcn_kernarg_segment_ptr(); asm volatile("" : "+s"(C.ka));
        C.rep = 0; run_phase(C, ph, shm);
#ifdef PROBE_MASK
        { const int sub_ = (ph - 1) % PH_PER_LAYER; if (ph > 0 && ph < N_PHASES - 1 && (((PROBE_MASK) >> sub_) & 1u)) { __syncthreads(); C.rep = 1; asm volatile("" : "+s"(C.rep)); run_phase(C, ph, shm); } }
#endif
        if (ph + 1 < P.ph_hi) xcd_barrier(xb);
    }
}

extern "C" void kernel_launch(void* const* d_in, const int* in_sizes, int n_in, void* d_out, int out_size, void* d_ws, size_t ws_size, hipStream_t stream) {
    static int grid = 0;
    if (grid == 0) {
        if (n_in != 38 || out_size != M_TOK * 1024 || ws_size < WS_TOTAL) { fprintf(stderr, "kernel_launch: unexpected shapes n_in %d out %d ws %zu (need %zu)\n", n_in, out_size, ws_size, (size_t)WS_TOTAL); grid = -1; return; }
        int dev = 0, cus = 0, per_cu = 0;
        (void)hipGetDevice(&dev); (void)hipDeviceGetAttribute(&cus, hipDeviceAttributeMultiprocessorCount, dev);
        if (hipFuncSetAttribute((const void*)mega_fwd, hipFuncAttributeMaxDynamicSharedMemorySize, LDS_BYTES) != hipSuccess) { fprintf(stderr, "kernel_launch: hipFuncSetAttribute failed\n"); grid = -1; return; }
        if (hipOccupancyMaxActiveBlocksPerMultiprocessor(&per_cu, (const void*)mega_fwd, 512, LDS_BYTES) != hipSuccess || per_cu < 1) { fprintf(stderr, "kernel_launch: occupancy query says %d\n", per_cu); per_cu = 1; }
        (void)hipGetLastError();
        grid = cus * per_cu;
    }
    if (grid < 0) return;
    Params p{};
    for (int i = 0; i < 38; ++i) p.in[i] = (const float*)d_in[i];
    p.out = (float*)d_out; p.ws = (unsigned char*)d_ws;
#ifdef DBG_FILL
    (void)hipMemsetAsync(d_ws, 0, WS_TOTAL, stream);
#endif
    (void)hipMemsetAsync((unsigned char*)d_ws + W_BAR, 0, 16384, stream);
#if SINGLE_LAUNCH
    p.ph_lo = 0; p.ph_hi = N_PHASES;
    void* args[] = {&p};
    hipError_t e = hipLaunchCooperativeKernel((const void*)mega_fwd, dim3(grid), dim3(512), args, LDS_BYTES, stream);
    if (e != hipSuccess) fprintf(stderr, "cooperative launch failed: %s (grid %d)\n", hipGetErrorString(e), grid);
#else
    for (int ph = 0; ph < N_PHASES; ++ph) { p.ph_lo = ph; p.ph_hi = ph + 1; hipLaunchKernelGGL(mega_fwd, dim3(grid), dim3(512), LDS_BYTES, stream, p); }
#endif
}
```
